# Optimizing an MI355X kernel written in HIP

```python
import math
import jax, jax.numpy as jnp
from jax import lax
import numpy as np

D_MODEL = 1024
BATCH = 4
SEQ = 4096
DEPTH = 4

N_MEM = 256
HEAD_DIM = 64
MIX_WIDTH = D_MODEL
MEM_HEADS = 4
MEM_WIDTH = MEM_HEADS * HEAD_DIM
MAIN_WIDTH = MIX_WIDTH - MEM_WIDTH
SB_HEADS = MAIN_WIDTH // HEAD_DIM
CONV_WIDTH = 3
D_FF = -(-8 * D_MODEL // (3 * 256)) * 256
N_A_LAYERS = DEPTH // 2
N_B_LAYERS = DEPTH - N_A_LAYERS
BLOCK_Q = 128
EPS = 1e-6

kernel_name = "shortconv_stickbreaking_yoco_hybrid"


def rmsnorm(x, g):
    xf = x.astype(jnp.float32)
    y = xf * lax.rsqrt(jnp.mean(xf * xf, axis=-1, keepdims=True) + EPS)
    return (y * g.astype(jnp.float32)).astype(x.dtype)


def causal_short_conv(u, w):
    c = u.shape[-1]
    return lax.conv_general_dilated(
        u, w[:, None, :].astype(u.dtype), window_strides=(1,),
        padding=[(CONV_WIDTH - 1, 0)],
        dimension_numbers=("NWC", "WIO", "NWC"),
        feature_group_count=c)


def memory_cross_attention(q, mem_k, mem_v):
    scale = 1.0 / math.sqrt(HEAD_DIM)
    s = jnp.einsum("bshd,bmhd->bhsm", q.astype(jnp.float32), mem_k.astype(jnp.float32)) * scale
    p = jax.nn.softmax(s, axis=-1)
    o = jnp.einsum("bhsm,bmhd->bshd", p, mem_v.astype(jnp.float32))
    return o.astype(q.dtype)


def stick_breaking_attention(q, k, v):
    b, s_len, h, d = q.shape
    scale = 1.0 / math.sqrt(d)
    qh = jnp.transpose(q, (0, 2, 1, 3)).astype(jnp.float32)
    kh = jnp.transpose(k, (0, 2, 1, 3)).astype(jnp.float32)
    vh = jnp.transpose(v, (0, 2, 1, 3)).astype(jnp.float32)
    outs = []
    for blk in range(s_len // BLOCK_Q):
        start = blk * BLOCK_Q
        end = start + BLOCK_Q
        qb = qh[:, :, start:end]
        kb = kh[:, :, :end]
        vb = vh[:, :, :end]
        z = jnp.einsum("bhtd,bhsd->bhts", qb, kb) * scale
        t_idx = start + jnp.arange(BLOCK_Q)[:, None]
        s_idx = jnp.arange(end)[None, :]
        causal = s_idx < t_idx
        log_not = jnp.where(causal, jax.nn.log_sigmoid(-z), 0.0)
        tail = lax.cumsum(log_not, axis=3, reverse=True) - log_not
        log_a = jax.nn.log_sigmoid(z) + tail
        a = jnp.where(causal, jnp.exp(log_a), 0.0)
        outs.append(jnp.einsum("bhts,bhsd->bhtd", a, vb))
    o = jnp.concatenate(outs, axis=2)
    return jnp.transpose(o, (0, 2, 1, 3)).astype(q.dtype)


def swiglu(h, w_gate, w_up, w_down):
    return (jax.nn.silu(h @ w_gate) * (h @ w_up)) @ w_down


def setup_inputs(seed: int = 0) -> dict:
    key = jax.random.key(seed)
    ks = jax.random.split(key, 16)
    f32 = jnp.float32

    def nrm(k, shape, fan_in):
        return jax.random.normal(k, shape, f32) * (fan_in ** -0.5)

    def gain(k, shape):
        return jnp.ones(shape, f32) + 0.02 * jax.random.normal(k, shape, f32)

    x = jax.random.normal(ks[0], (BATCH, SEQ, D_MODEL), f32)
    mem = jax.random.normal(ks[1], (BATCH, N_MEM, D_MODEL), f32)
    return {
        "x": x,
        "mem": mem,
        "mix_norm": gain(ks[2], (DEPTH, D_MODEL)),
        "a_in": nrm(ks[3], (N_A_LAYERS, D_MODEL, 3 * MAIN_WIDTH + MEM_WIDTH), D_MODEL),
        "conv_w": nrm(ks[4], (N_A_LAYERS, CONV_WIDTH, MAIN_WIDTH), CONV_WIDTH),
        "b_in": nrm(ks[5], (N_B_LAYERS, D_MODEL, MAIN_WIDTH + MEM_WIDTH), D_MODEL),
        "kv_norm": gain(ks[6], (D_MODEL,)),
        "w_kv_shared": nrm(ks[7], (D_MODEL, 2 * MAIN_WIDTH), D_MODEL),
        "w_mem_kv": nrm(ks[8], (DEPTH, D_MODEL, 2 * MEM_WIDTH), D_MODEL),
        "w_o": nrm(ks[9], (DEPTH, MIX_WIDTH, D_MODEL), MIX_WIDTH),
        "ffn_norm": gain(ks[10], (DEPTH, D_MODEL)),
        "w_gate": nrm(ks[11], (DEPTH, D_MODEL, D_FF), D_MODEL),
        "w_up": nrm(ks[12], (DEPTH, D_MODEL, D_FF), D_MODEL),
        "w_down": nrm(ks[13], (DEPTH, D_FF, D_MODEL), D_FF),
        "mem_norm": gain(ks[14], (D_MODEL,)),
        "final_norm": gain(ks[15], (D_MODEL,)),
    }


def reference(x, mem, mix_norm, a_in, conv_w, b_in, kv_norm, w_kv_shared, w_mem_kv,
              w_o, ffn_norm, w_gate, w_up, w_down, mem_norm, final_norm):
    b, s_len, _ = x.shape
    m_len = mem.shape[1]
    mem_n = rmsnorm(mem, mem_norm)
    k_sh = None
    v_sh = None
    for i in range(DEPTH):
        h = rmsnorm(x, mix_norm[i])
        mkv = (mem_n @ w_mem_kv[i]).reshape(b, m_len, 2, MEM_HEADS, HEAD_DIM)
        mem_k, mem_v = mkv[:, :, 0], mkv[:, :, 1]
        if i < N_A_LAYERS:
            p = h @ a_in[i]
            b_gate = p[..., :MAIN_WIDTH]
            c_gate = p[..., MAIN_WIDTH:2 * MAIN_WIDTH]
            u = p[..., 2 * MAIN_WIDTH:3 * MAIN_WIDTH]
            q_mem = p[..., 3 * MAIN_WIDTH:]
            y_main = b_gate * causal_short_conv(c_gate * u, conv_w[i])
        else:
            j = i - N_A_LAYERS
            p = h @ b_in[j]
            q_sb = p[..., :MAIN_WIDTH].reshape(b, s_len, SB_HEADS, HEAD_DIM)
            q_mem = p[..., MAIN_WIDTH:]
            y_main = stick_breaking_attention(q_sb, k_sh, v_sh).reshape(b, s_len, MAIN_WIDTH)
        y_mem = memory_cross_attention(
            q_mem.reshape(b, s_len, MEM_HEADS, HEAD_DIM), mem_k, mem_v
        ).reshape(b, s_len, MEM_WIDTH)
        x = x + jnp.concatenate([y_main, y_mem], axis=-1) @ w_o[i]
        x = x + swiglu(rmsnorm(x, ffn_norm[i]), w_gate[i], w_up[i], w_down[i])
        if i == N_A_LAYERS - 1:
            kv = (rmsnorm(x, kv_norm) @ w_kv_shared).reshape(b, s_len, 2, SB_HEADS, HEAD_DIM)
            k_sh, v_sh = kv[:, :, 0], kv[:, :, 1]
    return rmsnorm(x, final_norm)
```

```cpp
#include <hip/hip_runtime.h>
#include <hip/hip_cooperative_groups.h>
#include <cstdio>
#include <cstdint>
namespace cg = cooperative_groups;

#define LAS __attribute__((address_space(3)))
typedef unsigned short bf16_t;
typedef short bf16x8 __attribute__((ext_vector_type(8)));
typedef short s16x4 __attribute__((ext_vector_type(4)));
typedef float f32x4 __attribute__((ext_vector_type(4)));
typedef float f32x16 __attribute__((ext_vector_type(16)));
typedef unsigned u32x4 __attribute__((ext_vector_type(4)));
typedef unsigned u32x2 __attribute__((ext_vector_type(2)));

constexpr int SEQ = 4096, NB = 4, TT = NB * SEQ, DM = 1024, NMEM = 256, MROWS = NB * NMEM, FF = 2816, MAINW = 768, MEMW = 256, NHSB = 12, NHM = 4;
constexpr int PA = 2560;
constexpr int PB = 1024;
constexpr float EPS = 1e-6f, LOG2E = 1.4426950408889634f, LN2 = 0.6931471805599453f;

constexpr size_t MiB = 1u << 20;
constexpr size_t WS_SSQX = 1 * MiB;
constexpr size_t WS_SSQM = 2 * MiB;
constexpr size_t WS_MEMB = 3 * MiB;
constexpr size_t WS_MK = 5 * MiB;
constexpr size_t WS_MVT = 7 * MiB;
constexpr size_t WS_MKVW = 9 * MiB;
constexpr size_t WS_WSLOT = 13 * MiB, SLOT_BYTES = 24 * MiB;
constexpr size_t SL_WIN = 0, SL_WO = 5 * MiB, SL_WGU = 7 * MiB, SL_WD = 18 * MiB;
constexpr size_t WS_XB = 61 * MiB;
constexpr size_t WS_KSH = 93 * MiB;
constexpr size_t WS_VT = 117 * MiB;
constexpr size_t WS_PACT = 141 * MiB;
constexpr size_t WS_END = 229 * MiB;

constexpr int NWAVES = 8, LDS_BYTES = 147456;

namespace pg8 {
constexpr int BM = 256, BK = 64, HALF = 128, HTB = HALF * BK * 2, STAGE_BYTES = 8 * HTB, NXCD = 8, WGM = 8;
__host__ __device__ __forceinline__ int lds_byte(int r, int c) { const int st = (r >> 4) * 2 + (c >> 5), rr = r & 15, cc = c & 31, ob = rr * 64 + cc * 2; return st * 1024 + (ob ^ (((ob >> 9) & 1) << 5)); }
__host__ __device__ __forceinline__ void stage_rc(int b, int& R, int& C) { const int st = b / 1024, sb = b % 1024, swz = sb ^ (((sb >> 9) & 1) << 5); R = (st >> 1) * 16 + swz / 64; C = (st & 1) * 32 + (swz % 64) / 2; }
__host__ __device__ __forceinline__ int perm32(int rho) { const int n = rho >> 4, i = rho & 15; return 8 * (i >> 2) + 4 * n + (i & 3); }

struct Unit { int pm, pn; };
struct Gemm { const bf16_t* A; const bf16_t* Bt; int M, N, K, lda; };

struct StaticOrder {
    int nM, nN, nwg, G, c;
    __host__ __device__ void init(int M, int N, int G_, int c_) { nM = M / BM; nN = N / BM; nwg = nM * nN; G = G_; c = c_; }
    __host__ __device__ bool next(int i, Unit& u) const {
        const long L = (long)i * G + c; if (L >= nwg) return false;
        int wgid = (int)L; { const int q = nwg / NXCD, r = nwg % NXCD, xcd = wgid % NXCD, off = wgid / NXCD; wgid = (xcd < r ? xcd * (q + 1) : r * (q + 1) + (xcd - r) * q) + off; }
        const int nig = WGM * nN, gid = wgid / nig, fm = gid * WGM, gsz = (nM - fm) < WGM ? (nM - fm) : WGM;
        u.pm = fm + ((wgid % nig) % gsz); u.pn = (wgid % nig) / gsz; return true;
    }
};

__device__ __forceinline__ unsigned cvt_pk_bf16(float lo, float hi) { unsigned r; asm volatile("v_cvt_pk_bf16_f32 %0, %1, %2" : "=v"(r) : "v"(lo), "v"(hi)); return r; }

__device__ __forceinline__ float row_rs(const float* ssq, int row, int fq) {
    const f32x4 p = *(const f32x4*)(ssq + (size_t)row * 16 + 4 * fq);
    float s = (p[0] + p[1]) + (p[2] + p[3]);
    s += __shfl_xor(s, 16); s += __shfl_xor(s, 32);
    return __builtin_amdgcn_rsqf(s * (1.0f / 1024.0f) + EPS);
}
__device__ __forceinline__ void store_tile_normal(const f32x4 (&acc)[2][2][4][2], const float (&rs)[2][4], bf16_t* base, int ld, int row0, int col0) {
#pragma unroll
    for (int ai = 0; ai < 2; ++ai)
#pragma unroll
        for (int m = 0; m < 4; ++m) { bf16_t* rowp = base + (size_t)(row0 + ai * HALF + m * 16) * ld + col0; const float s = rs[ai][m];
#pragma unroll
            for (int bj = 0; bj < 2; ++bj) { const f32x4 v0 = acc[ai][bj][m][0] * s, v1 = acc[ai][bj][m][1] * s;
                u32x4 w; w.x = cvt_pk_bf16(v0[0], v0[1]); w.y = cvt_pk_bf16(v0[2], v0[3]); w.z = cvt_pk_bf16(v1[0], v1[1]); w.w = cvt_pk_bf16(v1[2], v1[3]);
                *(u32x4*)(rowp + bj * HALF) = w; } }
}
__device__ __forceinline__ void store_tile_trans(const f32x4 (&acc)[2][2][4][2], const float (&rs)[2][4], bf16_t* OT, int sh, int nct, int row0, int col0) {
#pragma unroll
    for (int ai = 0; ai < 2; ++ai)
#pragma unroll
        for (int m = 0; m < 4; ++m) { const int row = row0 + ai * HALF + m * 16; const float s = rs[ai][m];
            const size_t rb = (size_t)(row >> sh) * nct; const int rr = row & ((1 << sh) - 1);
#pragma unroll
            for (int bj = 0; bj < 2; ++bj)
#pragma unroll
                for (int n = 0; n < 2; ++n) { const f32x4 v = acc[ai][bj][m][n] * s; const unsigned w0 = cvt_pk_bf16(v[0], v[1]), w1 = cvt_pk_bf16(v[2], v[3]);
                    const int c = col0 + bj * HALF + 4 * n;
                    OT[((rb + c + 0) << sh) + rr] = (bf16_t)(w0 & 0xffffu); OT[((rb + c + 1) << sh) + rr] = (bf16_t)(w0 >> 16);
                    OT[((rb + c + 2) << sh) + rr] = (bf16_t)(w1 & 0xffffu); OT[((rb + c + 3) << sh) + rr] = (bf16_t)(w1 >> 16); } }
}
struct EpiProj {
    static constexpr bool PERM = true;
    const float* ssq; bf16_t* O0; int ld0, nt0; bf16_t* O1; int ld1, nt1; bf16_t* OT; int sh, nct;
    __device__ __forceinline__ void operator()(const f32x4 (&acc)[2][2][4][2], const Unit& u, int wr, int wc, int fr, int fq) const {
        const int row0 = u.pm * BM + wr * 64 + fr; float rs[2][4];
#pragma unroll
        for (int ai = 0; ai < 2; ++ai)
#pragma unroll
            for (int m = 0; m < 4; ++m) rs[ai][m] = row_rs(ssq, row0 + ai * HALF + m * 16, fq);
        const int cw = wc * 32 + 8 * fq;
        if (u.pn < nt0) store_tile_normal(acc, rs, O0, ld0, row0, u.pn * BM + cw);
        else if (u.pn < nt0 + nt1) store_tile_normal(acc, rs, O1, ld1, row0, (u.pn - nt0) * BM + cw);
        else store_tile_trans(acc, rs, OT, sh, nct, row0, (u.pn - nt0 - nt1) * BM + cw);
    }
};
struct EpiMKV {
    static constexpr bool PERM = true;
    const float* ssq; bf16_t* MK; bf16_t* MVT;
    __device__ __forceinline__ void operator()(const f32x4 (&acc)[2][2][4][2], const Unit& u, int wr, int wc, int fr, int fq) const {
        const int row0 = u.pm * BM + wr * 64 + fr; float rs[2][4];
#pragma unroll
        for (int ai = 0; ai < 2; ++ai)
#pragma unroll
            for (int m = 0; m < 4; ++m) rs[ai][m] = row_rs(ssq, row0 + ai * HALF + m * 16, fq);
        const int cw = wc * 32 + 8 * fq, l = u.pn >> 1;
        if ((u.pn & 1) == 0) store_tile_normal(acc, rs, MK + (size_t)l * MROWS * 256, 256, row0, cw);
        else store_tile_trans(acc, rs, MVT + (size_t)l * MROWS * 256, 8, 256, row0, cw);
    }
};
struct EpiSwiGLU {
    static constexpr bool PERM = true;
    const float* ssq; bf16_t* O; int ldc;
    __device__ __forceinline__ void operator()(const f32x4 (&acc)[2][2][4][2], const Unit& u, int wr, int wc, int fr, int fq) const {
        const int row0 = u.pm * BM + wr * 64 + fr, col0 = u.pn * HALF + wc * 32 + 8 * fq;
#pragma unroll
        for (int ai = 0; ai < 2; ++ai)
#pragma unroll
            for (int m = 0; m < 4; ++m) { const int row = row0 + ai * HALF + m * 16; const float s = row_rs(ssq, row, fq);
                float o[8];
#pragma unroll
                for (int n = 0; n < 2; ++n)
#pragma unroll
                    for (int i = 0; i < 4; ++i) { const float g = acc[ai][0][m][n][i] * s, up = acc[ai][1][m][n][i] * s;
                        o[4 * n + i] = g * __builtin_amdgcn_rcpf(1.0f + __builtin_amdgcn_exp2f(-g * LOG2E)) * up; }
                u32x4 w; w.x = cvt_pk_bf16(o[0], o[1]); w.y = cvt_pk_bf16(o[2], o[3]); w.z = cvt_pk_bf16(o[4], o[5]); w.w = cvt_pk_bf16(o[6], o[7]);
                *(u32x4*)(O + (size_t)row * ldc + col0) = w; }
    }
};
struct EpiRes {
    static constexpr bool PERM = true;
    const float* base; float* out; bf16_t* xb; float* ssq;
    __device__ __forceinline__ void operator()(const f32x4 (&acc)[2][2][4][2], const Unit& u, int wr, int wc, int fr, int fq) const {
        const int row0 = u.pm * BM + wr * 64 + fr, col0 = u.pn * BM + wc * 32 + 8 * fq;
#pragma unroll
        for (int ai = 0; ai < 2; ++ai)
#pragma unroll
            for (int m = 0; m < 4; ++m) { const int row = row0 + ai * HALF + m * 16; const size_t off = (size_t)row * DM + col0; float sq = 0.f;
#pragma unroll
                for (int bj = 0; bj < 2; ++bj) { const f32x4 b0 = *(const f32x4*)(base + off + bj * HALF), b1 = *(const f32x4*)(base + off + bj * HALF + 4);
                    const f32x4 x0 = b0 + acc[ai][bj][m][0], x1 = b1 + acc[ai][bj][m][1];
                    *(f32x4*)(out + off + bj * HALF) = x0; *(f32x4*)(out + off + bj * HALF + 4) = x1;
                    u32x4 w; w.x = cvt_pk_bf16(x0[0], x0[1]); w.y = cvt_pk_bf16(x0[2], x0[3]); w.z = cvt_pk_bf16(x1[0], x1[1]); w.w = cvt_pk_bf16(x1[2], x1[3]);
                    *(u32x4*)(xb + off + bj * HALF) = w;
                    sq += (x0[0] * x0[0] + x0[1] * x0[1]) + (x0[2] * x0[2] + x0[3] * x0[3]) + (x1[0] * x1[0] + x1[1] * x1[1]) + (x1[2] * x1[2] + x1[3] * x1[3]); }
                sq += __shfl_xor(sq, 16); sq += __shfl_xor(sq, 32);
                if (fq == 0) ssq[(size_t)row * 16 + u.pn * 4 + wc] = sq; }
    }
};

template <class Epi, class Sched, bool ALIGN_EPI>
__device__ __forceinline__ void gemm_phase(LAS unsigned char* lds, const Gemm g, const Sched& S, const Epi& E) {
    int tid = threadIdx.x; asm volatile("" : "+v"(tid));
    const int wid = __builtin_amdgcn_readfirstlane(tid >> 6), lane = tid & 63, wr = wid >> 2, wc = wid & 3, fr = lane & 15, fq = lane >> 4;
    const int K = g.K, nt = K / BK;
    unsigned voffA[2], voffB[2];
#pragma unroll
    for (int i = 0; i < 2; ++i) { int R, C; stage_rc(tid * 16 + i * 8192, R, C); const int Rb = Epi::PERM ? ((R & ~31) + perm32(R & 31)) : R;
        voffA[i] = (unsigned)(R * g.lda + C) * 2u; voffB[i] = (unsigned)(Rb * K + C) * 2u; }
    const size_t kstep = (size_t)(BK * 2);
    const size_t hstepA = (size_t)HALF * g.lda * 2, hstepB = (size_t)HALF * K * 2;
    const size_t tstepA = 2 * hstepA, tstepB = 2 * hstepB;
    const unsigned ldsw = (unsigned)wid * 1024u;
    const int aoff = lds_byte(wr * 64 + fr, fq * 8), boff = lds_byte(wc * 32 + fr, fq * 8);
#define PG8_SA(b, h) (((b) * 2 + (h)) * HTB)
#define PG8_SB(b, h) ((4 + (b) * 2 + (h)) * HTB)
#define PG8_STAGE(bufoff, gbase, voff) do { _Pragma("unroll") for (int _i = 0; _i < 2; ++_i) \
        __builtin_amdgcn_global_load_lds((const unsigned*)((const char*)(gbase) + (voff)[_i]), (LAS unsigned*)(lds + (bufoff) + ldsw + _i * 8192), 16, 0, 0); } while (0)
#define PG8_LDA(dst, b, h) do { _Pragma("unroll") for (int m = 0; m < 4; ++m) _Pragma("unroll") for (int k = 0; k < 2; ++k) dst[m][k] = *(const LAS bf16x8*)(lds + PG8_SA(b, h) + aoff + m * 2048 + k * 1024); } while (0)
#define PG8_LDB(dst, b, h) do { _Pragma("unroll") for (int n = 0; n < 2; ++n) _Pragma("unroll") for (int k = 0; k < 2; ++k) dst[n][k] = *(const LAS bf16x8*)(lds + PG8_SB(b, h) + boff + n * 2048 + k * 1024); } while (0)
#define PG8_MMA(ai, bj, At, Bt) do { __builtin_amdgcn_s_setprio(1); _Pragma("unroll") for (int m = 0; m < 4; ++m) _Pragma("unroll") for (int n = 0; n < 2; ++n) _Pragma("unroll") for (int k = 0; k < 2; ++k) \
        acc[ai][bj][m][n] = __builtin_amdgcn_mfma_f32_16x16x32_bf16(Bt[n][k], At[m][k], acc[ai][bj][m][n], 0, 0, 0); __builtin_amdgcn_s_setprio(0); } while (0)
#define PG8_WAIT_V(n) asm volatile("s_waitcnt vmcnt(" #n ")" ::: "memory")
#define PG8_WAIT_L(n) asm volatile("s_waitcnt lgkmcnt(" #n ")" ::: "memory")
#define PG8_BAR __builtin_amdgcn_s_barrier()
#define PG8_SCHED __builtin_amdgcn_sched_barrier(0)
    Unit cur, nxt; int ui = 0;
    if (!S.next(0, cur)) return;
    f32x4 acc[2][2][4][2];
#pragma unroll
    for (int a = 0; a < 2; ++a)
#pragma unroll
        for (int b = 0; b < 2; ++b)
#pragma unroll
            for (int m = 0; m < 4; ++m)
#pragma unroll
                for (int n = 0; n < 2; ++n) acc[a][b][m][n] = (f32x4){0.f, 0.f, 0.f, 0.f};
    bf16x8 At[4][2], B0[2][2], B1[2][2];
    const char* cA = (const char*)g.A + (size_t)cur.pm * tstepA; const char* cB = (const char*)g.Bt + (size_t)cur.pn * tstepB;
    PG8_STAGE(PG8_SB(0, 0), cB, voffB); PG8_STAGE(PG8_SB(0, 1), cB + hstepB, voffB); PG8_STAGE(PG8_SA(0, 0), cA, voffA); PG8_STAGE(PG8_SA(0, 1), cA + hstepA, voffA);
    if (wr == 1) PG8_BAR;
    PG8_WAIT_V(2); PG8_BAR;
    PG8_STAGE(PG8_SB(1, 0), cB + kstep, voffB); PG8_STAGE(PG8_SA(1, 0), cA + kstep, voffA); PG8_STAGE(PG8_SB(1, 1), cB + hstepB + kstep, voffB);
    PG8_WAIT_V(6); PG8_BAR;
    for (;;) {
        const bool has_next = S.next(ui + 1, nxt);
        const char* nA = has_next ? (const char*)g.A + (size_t)nxt.pm * tstepA : cA; const char* nB = has_next ? (const char*)g.Bt + (size_t)nxt.pn * tstepB : cB;
        for (int t = 0; t < nt; t += 2) {
            const bool last = (t == nt - 2);
            const char* a1 = cA + (size_t)(t + 1) * kstep;
            const char* a2 = last ? nA : cA + (size_t)(t + 2) * kstep; const char* b2 = last ? nB : cB + (size_t)(t + 2) * kstep;
            const char* a3 = a2 + kstep; const char* b3 = b2 + kstep;
            PG8_LDB(B0, 0, 0); PG8_LDB(B1, 0, 1); PG8_SCHED; PG8_LDA(At, 0, 0); PG8_STAGE(PG8_SA(1, 1), a1 + hstepA, voffA);
            PG8_WAIT_V(8); PG8_WAIT_L(0); PG8_BAR; PG8_MMA(0, 0, At, B0); PG8_MMA(0, 1, At, B1); PG8_BAR; PG8_SCHED;
            PG8_LDA(At, 0, 1); PG8_STAGE(PG8_SB(0, 0), b2, voffB); PG8_STAGE(PG8_SB(0, 1), b2 + hstepB, voffB); PG8_STAGE(PG8_SA(0, 0), a2, voffA);
            PG8_WAIT_V(8); PG8_WAIT_L(0); PG8_BAR; PG8_MMA(1, 0, At, B0); PG8_MMA(1, 1, At, B1); PG8_BAR; PG8_SCHED;
            PG8_LDB(B0, 1, 0); PG8_LDB(B1, 1, 1); PG8_SCHED; PG8_LDA(At, 1, 0); PG8_STAGE(PG8_SA(0, 1), a2 + hstepA, voffA);
            PG8_WAIT_V(8); PG8_WAIT_L(0); PG8_BAR; PG8_MMA(0, 0, At, B0); PG8_MMA(0, 1, At, B1); PG8_BAR; PG8_SCHED;
            PG8_LDA(At, 1, 1); PG8_STAGE(PG8_SB(1, 0), b3, voffB); PG8_STAGE(PG8_SB(1, 1), b3 + hstepB, voffB); PG8_STAGE(PG8_SA(1, 0), a3, voffA);
            PG8_WAIT_V(8); PG8_WAIT_L(0); PG8_BAR; PG8_MMA(1, 0, At, B0); PG8_MMA(1, 1, At, B1); PG8_BAR; PG8_SCHED;
        }
        if constexpr (ALIGN_EPI) { if (wr == 0) PG8_BAR; }
        E(acc, cur, wr, wc, fr, fq);
        if (!has_next) break;
#pragma unroll
        for (int a = 0; a < 2; ++a)
#pragma unroll
            for (int b = 0; b < 2; ++b)
#pragma unroll
                for (int m = 0; m < 4; ++m)
#pragma unroll
                    for (int n = 0; n < 2; ++n) acc[a][b][m][n] = (f32x4){0.f, 0.f, 0.f, 0.f};
        cur = nxt; cA = nA; cB = nB; ++ui;
        if constexpr (ALIGN_EPI) { if (wr == 1) PG8_BAR; }
    }
    PG8_WAIT_V(0);
    if constexpr (!ALIGN_EPI) { if (wr == 0) PG8_BAR; }
    PG8_BAR;
#undef PG8_SA
#undef PG8_SB
#undef PG8_STAGE
#undef PG8_LDA
#undef PG8_LDB
#undef PG8_MMA
#undef PG8_WAIT_V
#undef PG8_WAIT_L
#undef PG8_BAR
#undef PG8_SCHED
}
}

__device__ __forceinline__ float wave_sum(float v) {
#pragma unroll
    for (int o = 1; o < 64; o <<= 1) v += __shfl_xor(v, o);
    return v;
}
__device__ __forceinline__ unsigned pk2(float lo, float hi) { return pg8::cvt_pk_bf16(lo, hi); }
__device__ __forceinline__ float bf_lo(unsigned w) { return __uint_as_float(w << 16); }
__device__ __forceinline__ float bf_hi(unsigned w) { return __uint_as_float(w & 0xffff0000u); }
__device__ __forceinline__ int crow(int r, int hi) { return (r & 3) + 8 * (r >> 2) + 4 * hi; }

__device__ __forceinline__ void tr_item(const float* W, int N, int k0, int n0, const float* gain, float scale, bf16_t* WT, int Kd, int drow0, LAS float* scr, int lane) {
#pragma unroll 8
    for (int i = 0; i < 32; ++i) { const int kk = 2 * i + (lane >> 5); const float g = gain ? gain[k0 + kk] * scale : scale;
        scr[kk * 33 + (lane & 31)] = W[(size_t)(k0 + kk) * N + n0 + (lane & 31)] * g; }
    asm volatile("s_waitcnt lgkmcnt(0)" ::: "memory");
    const int c = lane & 7;
#pragma unroll
    for (int j = 0; j < 4; ++j) { const int n = (lane >> 3) + 8 * j; const LAS float* s = scr + (8 * c) * 33 + n;
        u32x4 o; o.x = pk2(s[0 * 33], s[1 * 33]); o.y = pk2(s[2 * 33], s[3 * 33]); o.z = pk2(s[4 * 33], s[5 * 33]); o.w = pk2(s[6 * 33], s[7 * 33]);
        *(u32x4*)(WT + (size_t)(drow0 + n) * Kd + k0 + 8 * c) = o; }
    asm volatile("s_waitcnt lgkmcnt(0)" ::: "memory");
}
enum { MAP_ID = 0, MAP_AIN = 1, MAP_GATE = 2, MAP_UP = 3 };
__device__ __forceinline__ void conv_job(int& base, const float* W, int K, int N, const float* gain, float scale, bf16_t* WT, int Kd, int map, int row_off, LAS float* scr, int gw, int ngw, int lane) {
    const int nblk = N / 32, nitems = (K / 64) * nblk;
    int first = (gw - (base % ngw)); if (first < 0) first += ngw;
    for (int it = first; it < nitems; it += ngw) {
        const int kb = it / nblk, nb = it % nblk, n0 = 32 * nb; int drow0 = row_off + n0; float sc = scale;
        if (map == MAP_AIN) { if (n0 < 768) drow0 = n0; else if (n0 < 1536) drow0 = n0 - 768 + 1024; else if (n0 < 2304) drow0 = n0 - 1536 + 1792; else { drow0 = n0 - 2304 + 768; sc = 0.125f; } }
        else if (map == MAP_GATE) drow0 = (n0 >> 7) * 256 + (n0 & 127);
        else if (map == MAP_UP) drow0 = (n0 >> 7) * 256 + 128 + (n0 & 127);
        tr_item(W, N, 64 * kb, n0, gain, sc, WT, Kd, drow0, scr, lane);
    }
    base += nitems;
}

struct Args { const float* in[16]; float* out; unsigned char* ws; };

__device__ __forceinline__ void convert_layer(const Args& a, int l, int& base, LAS float* scr, int gw, int ngw, int lane) {
    unsigned char* slot = a.ws + WS_WSLOT + (size_t)(l & 1) * SLOT_BYTES;
    bf16_t* WIN = (bf16_t*)(slot + SL_WIN); bf16_t* WO = (bf16_t*)(slot + SL_WO); bf16_t* WGU = (bf16_t*)(slot + SL_WGU); bf16_t* WD = (bf16_t*)(slot + SL_WD);
    const float* mixg = a.in[2] + (size_t)l * DM; const float* ffng = a.in[10] + (size_t)l * DM;
    if (l < 2) conv_job(base, a.in[3] + (size_t)l * DM * PA, DM, PA, mixg, 1.0f, WIN, DM, MAP_AIN, 0, scr, gw, ngw, lane);
    else {
        conv_job(base, a.in[5] + (size_t)(l - 2) * DM * DM, DM, DM, mixg, 0.125f, WIN, DM, MAP_ID, 0, scr, gw, ngw, lane);
        if (l == 2) conv_job(base, a.in[7], DM, 2 * MAINW, a.in[6], 1.0f, WIN, DM, MAP_ID, DM, scr, gw, ngw, lane);
    }
    conv_job(base, a.in[9] + (size_t)l * DM * DM, DM, DM, nullptr, 1.0f, WO, DM, MAP_ID, 0, scr, gw, ngw, lane);
    conv_job(base, a.in[11] + (size_t)l * DM * FF, DM, FF, ffng, 1.0f, WGU, DM, MAP_GATE, 0, scr, gw, ngw, lane);
    conv_job(base, a.in[12] + (size_t)l * DM * FF, DM, FF, ffng, 1.0f, WGU, DM, MAP_UP, 0, scr, gw, ngw, lane);
    conv_job(base, a.in[13] + (size_t)l * FF * DM, FF, DM, nullptr, 1.0f, WD, FF, MAP_ID, 0, scr, gw, ngw, lane);
}

__device__ __forceinline__ void row_to_bf16_ssq(const float* xrow, bf16_t* orow, float* ssq16, int lane) {
    const f32x4* xr = (const f32x4*)xrow + lane; f32x4 v[4]; float s = 0.f;
#pragma unroll
    for (int j = 0; j < 4; ++j) { v[j] = xr[64 * j]; s += (v[j][0] * v[j][0] + v[j][1] * v[j][1]) + (v[j][2] * v[j][2] + v[j][3] * v[j][3]); }
    s = wave_sum(s);
    u32x2* o8 = (u32x2*)orow + lane;
#pragma unroll
    for (int j = 0; j < 4; ++j) { u32x2 w; w.x = pk2(v[j][0], v[j][1]); w.y = pk2(v[j][2], v[j][3]); o8[64 * j] = w; }
    if (lane < 4) *(f32x4*)(ssq16 + 4 * lane) = (f32x4){lane == 0 ? s : 0.f, 0.f, 0.f, 0.f};
}
__device__ __forceinline__ void final_row(float* xrow, const float* g, int lane) {
    f32x4* xr = (f32x4*)xrow + lane; const f32x4* gr = (const f32x4*)g + lane; f32x4 v[4]; float s = 0.f;
#pragma unroll
    for (int j = 0; j < 4; ++j) { v[j] = xr[64 * j]; s += (v[j][0] * v[j][0] + v[j][1] * v[j][1]) + (v[j][2] * v[j][2] + v[j][3] * v[j][3]); }
    s = wave_sum(s); const float rs = 1.0f / sqrtf(s * (1.0f / 1024.0f) + EPS);
#pragma unroll
    for (int j = 0; j < 4; ++j) xr[64 * j] = v[j] * rs * gr[64 * j];
}

__device__ __forceinline__ void conv_items(bf16_t* P, const float* cw, int gtid, int nthreads) {
    for (int it = gtid; it < (TT / 16) * 96; it += nthreads) {
        const int cgp = it % 96, ch = it / 96, row0 = ch * 16, c0 = cgp * 8, t0 = row0 & (SEQ - 1);
        float w0[8], w1[8], w2[8], p2[8], p1[8];
#pragma unroll
        for (int i = 0; i < 8; ++i) { w0[i] = cw[c0 + i]; w1[i] = cw[MAINW + c0 + i]; w2[i] = cw[2 * MAINW + c0 + i]; p2[i] = 0.f; p1[i] = 0.f; }
        if (t0 >= 2) {
            const bf16_t* r2 = P + (size_t)(row0 - 2) * PA; const bf16_t* r1 = P + (size_t)(row0 - 1) * PA;
            const u32x4 g2 = *(const u32x4*)(r2 + 1024 + c0), u2 = *(const u32x4*)(r2 + 1792 + c0), g1 = *(const u32x4*)(r1 + 1024 + c0), u1 = *(const u32x4*)(r1 + 1792 + c0);
#pragma unroll
            for (int i = 0; i < 4; ++i) { p2[2 * i] = bf_lo(g2[i]) * bf_lo(u2[i]); p2[2 * i + 1] = bf_hi(g2[i]) * bf_hi(u2[i]); p1[2 * i] = bf_lo(g1[i]) * bf_lo(u1[i]); p1[2 * i + 1] = bf_hi(g1[i]) * bf_hi(u1[i]); }
        }
#pragma unroll 4
        for (int i = 0; i < 16; ++i) {
            bf16_t* r = P + (size_t)(row0 + i) * PA;
            const u32x4 gg = *(const u32x4*)(r + 1024 + c0), uu = *(const u32x4*)(r + 1792 + c0), bb = *(const u32x4*)(r + c0);
            float cu[8], y[8];
#pragma unroll
            for (int j = 0; j < 4; ++j) { cu[2 * j] = bf_lo(gg[j]) * bf_lo(uu[j]); cu[2 * j + 1] = bf_hi(gg[j]) * bf_hi(uu[j]); }
#pragma unroll
            for (int j = 0; j < 4; ++j) { y[2 * j] = bf_lo(bb[j]) * (w0[2 * j] * p2[2 * j] + w1[2 * j] * p1[2 * j] + w2[2 * j] * cu[2 * j]);
                y[2 * j + 1] = bf_hi(bb[j]) * (w0[2 * j + 1] * p2[2 * j + 1] + w1[2 * j + 1] * p1[2 * j + 1] + w2[2 * j + 1] * cu[2 * j + 1]); }
            u32x4 o; o.x = pk2(y[0], y[1]); o.y = pk2(y[2], y[3]); o.z = pk2(y[4], y[5]); o.w = pk2(y[6], y[7]);
            *(u32x4*)(r + c0) = o;
#pragma unroll
            for (int j = 0; j < 8; ++j) { p2[j] = p1[j]; p1[j] = cu[j]; }
        }
    }
}

__device__ __forceinline__ float half_max(float m) { auto rr = __builtin_amdgcn_permlane32_swap(__float_as_uint(m), __float_as_uint(m), false, false); return fmaxf(__uint_as_float(rr[0]), __uint_as_float(rr[1])); }
__device__ __forceinline__ bf16x8 pack8(const f32x16& p, int s) {
    u32x4 w; w.x = pk2(p[8 * s + 0], p[8 * s + 1]); w.y = pk2(p[8 * s + 2], p[8 * s + 3]); w.z = pk2(p[8 * s + 4], p[8 * s + 5]); w.w = pk2(p[8 * s + 6], p[8 * s + 7]);
    return __builtin_bit_cast(bf16x8, w);
}
__device__ __forceinline__ bf16x8 vfrag(const bf16_t* p) {
    const s16x4 lo = *(const s16x4*)p, hi = *(const s16x4*)(p + 8);
    return (bf16x8){lo[0], lo[1], lo[2], lo[3], hi[0], hi[1], hi[2], hi[3]};
}
__device__ __forceinline__ void store_o(bf16_t* qp, const f32x16& o0, const f32x16& o1, float sc, int hi) {
#pragma unroll
    for (int g = 0; g < 4; ++g) { u32x2 w; w.x = pk2(o0[4 * g] * sc, o0[4 * g + 1] * sc); w.y = pk2(o0[4 * g + 2] * sc, o0[4 * g + 3] * sc); *(u32x2*)(qp + 8 * g + 4 * hi) = w; }
#pragma unroll
    for (int g = 0; g < 4; ++g) { u32x2 w; w.x = pk2(o1[4 * g] * sc, o1[4 * g + 1] * sc); w.y = pk2(o1[4 * g + 2] * sc, o1[4 * g + 3] * sc); *(u32x2*)(qp + 32 + 8 * g + 4 * hi) = w; }
}

__device__ __forceinline__ void mem_attn_item(bf16_t* P, int pitch, const bf16_t* MK, const bf16_t* MVT, int item, int lane) {
    const int qb = item & 127, hm = (item >> 7) & 3, b = item >> 9, r32 = lane & 31, hi = lane >> 5;
    bf16_t* qp = P + (size_t)(b * SEQ + qb * 32 + r32) * pitch + MAINW + hm * 64;
    bf16x8 qf[4];
#pragma unroll
    for (int d0 = 0; d0 < 4; ++d0) qf[d0] = *(const bf16x8*)(qp + d0 * 16 + hi * 8);
    const bf16_t* kp = MK + (size_t)(b * NMEM + r32) * 256 + hm * 64 + hi * 8;
    f32x16 sc[8];
#pragma unroll
    for (int mt = 0; mt < 8; ++mt) { f32x16 z = {};
#pragma unroll
        for (int d0 = 0; d0 < 4; ++d0) { const bf16x8 kf = *(const bf16x8*)(kp + (size_t)mt * 32 * 256 + d0 * 16); z = __builtin_amdgcn_mfma_f32_32x32x16_bf16(kf, qf[d0], z, 0, 0, 0); }
        sc[mt] = z; }
    float mx = -INFINITY;
#pragma unroll
    for (int mt = 0; mt < 8; ++mt)
#pragma unroll
        for (int r = 0; r < 16; ++r) mx = fmaxf(mx, sc[mt][r]);
    mx = half_max(mx);
    float l = 0.f;
#pragma unroll
    for (int mt = 0; mt < 8; ++mt)
#pragma unroll
        for (int r = 0; r < 16; ++r) { const float e = __builtin_amdgcn_exp2f((sc[mt][r] - mx) * LOG2E); sc[mt][r] = e; l += e; }
    { auto rr = __builtin_amdgcn_permlane32_swap(__float_as_uint(l), __float_as_uint(l), false, false); l = __uint_as_float(rr[0]) + __uint_as_float(rr[1]); }
    f32x16 o0 = {}, o1 = {};
    const bf16_t* vp = MVT + (size_t)((b * NHM + hm) * 64 + r32) * NMEM + 4 * hi;
#pragma unroll
    for (int mt = 0; mt < 8; ++mt)
#pragma unroll
        for (int s = 0; s < 2; ++s) { const bf16x8 pf = pack8(sc[mt], s);
            o0 = __builtin_amdgcn_mfma_f32_32x32x16_bf16(vfrag(vp + mt * 32 + 16 * s), pf, o0, 0, 0, 0);
            o1 = __builtin_amdgcn_mfma_f32_32x32x16_bf16(vfrag(vp + 32 * NMEM + mt * 32 + 16 * s), pf, o1, 0, 0, 0); }
    store_o(qp, o0, o1, 1.0f / l, hi);
}

__device__ __forceinline__ void sb_attn_item(bf16_t* P, const bf16_t* Ksh, const bf16_t* VT, int item, int lane) {
    const int qb = item & 127, bh = item >> 7, h = bh % NHSB, b = bh / NHSB, r32 = lane & 31, hi = lane >> 5;
    bf16_t* qp = P + (size_t)(b * SEQ + qb * 32 + r32) * PB + h * 64;
    bf16x8 qf[4];
#pragma unroll
    for (int d0 = 0; d0 < 4; ++d0) qf[d0] = *(const bf16x8*)(qp + d0 * 16 + hi * 8);
    const bf16_t* kbase = Ksh + (size_t)(b * SEQ + r32) * MAINW + h * 64 + hi * 8;
    const bf16_t* vbase = VT + (size_t)((b * NHSB + h) * 64 + r32) * SEQ + 4 * hi;
    float C = 0.f; f32x16 o0 = {}, o1 = {};
    for (int kt = qb; kt >= 0; --kt) {
        const bf16_t* kp = kbase + (size_t)kt * 32 * MAINW;
        f32x16 z = {};
#pragma unroll
        for (int d0 = 0; d0 < 4; ++d0) { const bf16x8 kf = *(const bf16x8*)(kp + d0 * 16); z = __builtin_amdgcn_mfma_f32_32x32x16_bf16(kf, qf[d0], z, 0, 0, 0); }
        const bf16x8 v00 = vfrag(vbase + kt * 32), v01 = vfrag(vbase + kt * 32 + 16), v10 = vfrag(vbase + 32 * SEQ + kt * 32), v11 = vfrag(vbase + 32 * SEQ + kt * 32 + 16);
        const bool diag = (kt == qb);
        float ln[16], zl[16];
#pragma unroll
        for (int r = 0; r < 16; ++r) { const float zz = z[r], e = __builtin_amdgcn_exp2f(-fabsf(zz) * LOG2E), sp = fmaxf(zz, 0.f) + LN2 * __builtin_amdgcn_logf(1.0f + e);
            const bool valid = !diag || (crow(r, hi) < r32);
            ln[r] = valid ? -sp : 0.f; zl[r] = valid ? (zz - sp) : -INFINITY; }
        float G0[4], G1[4];
#pragma unroll
        for (int g = 0; g < 4; ++g) { const float gs = (ln[4 * g] + ln[4 * g + 1]) + (ln[4 * g + 2] + ln[4 * g + 3]);
            const float ot = __shfl_xor(gs, 32); G0[g] = hi ? ot : gs; G1[g] = hi ? gs : ot; }
        float R = C;
        f32x16 a;
#pragma unroll
        for (int g = 3; g >= 0; --g) {
            float tl = R + (hi == 0 ? G1[g] : 0.f);
            a[4 * g + 3] = __builtin_amdgcn_exp2f((zl[4 * g + 3] + tl) * LOG2E); tl += ln[4 * g + 3];
            a[4 * g + 2] = __builtin_amdgcn_exp2f((zl[4 * g + 2] + tl) * LOG2E); tl += ln[4 * g + 2];
            a[4 * g + 1] = __builtin_amdgcn_exp2f((zl[4 * g + 1] + tl) * LOG2E); tl += ln[4 * g + 1];
            a[4 * g + 0] = __builtin_amdgcn_exp2f((zl[4 * g + 0] + tl) * LOG2E);
            R += G0[g] + G1[g];
        }
        C = R;
        const bf16x8 p0 = pack8(a, 0), p1 = pack8(a, 1);
        o0 = __builtin_amdgcn_mfma_f32_32x32x16_bf16(v00, p0, o0, 0, 0, 0); o0 = __builtin_amdgcn_mfma_f32_32x32x16_bf16(v01, p1, o0, 0, 0, 0);
        o1 = __builtin_amdgcn_mfma_f32_32x32x16_bf16(v10, p0, o1, 0, 0, 0); o1 = __builtin_amdgcn_mfma_f32_32x32x16_bf16(v11, p1, o1, 0, 0, 0);
        if (__all(C < -110.0f)) break;
    }
    store_o(qp, o0, o1, 1.0f, hi);
}

__global__ void __launch_bounds__(NWAVES * 64, 2) fwd_megakernel(Args a) {
    extern __shared__ __attribute__((aligned(16))) unsigned char lds_raw[];
    cg::grid_group grid = cg::this_grid();
    LAS unsigned char* lds = (LAS unsigned char*)lds_raw;
    const int tid = threadIdx.x, lane = tid & 63, wave = __builtin_amdgcn_readfirstlane(tid >> 6);
    const int G = gridDim.x, bx = blockIdx.x;
    const int gw = bx * NWAVES + wave, ngw = G * NWAVES, gtid = bx * (NWAVES * 64) + tid, nthreads = G * NWAVES * 64;
    unsigned char* ws = a.ws;
    float* X = a.out;
    float* SSQX = (float*)(ws + WS_SSQX); float* SSQM = (float*)(ws + WS_SSQM);
    bf16_t* MEMB = (bf16_t*)(ws + WS_MEMB); bf16_t* MK = (bf16_t*)(ws + WS_MK); bf16_t* MVT = (bf16_t*)(ws + WS_MVT); bf16_t* MKVW = (bf16_t*)(ws + WS_MKVW);
    bf16_t* XB = (bf16_t*)(ws + WS_XB); bf16_t* KSH = (bf16_t*)(ws + WS_KSH); bf16_t* VT = (bf16_t*)(ws + WS_VT); bf16_t* PACT = (bf16_t*)(ws + WS_PACT);
    LAS float* scr = (LAS float*)(lds + wave * 16384);

    {
        int base = 0;
#pragma unroll 1
        for (int l = 0; l < 4; ++l) conv_job(base, a.in[8] + (size_t)l * DM * 512, DM, 512, a.in[14], 1.0f, MKVW, DM, MAP_ID, l * 512, scr, gw, ngw, lane);
        convert_layer(a, 0, base, scr, gw, ngw, lane);
        convert_layer(a, 1, base, scr, gw, ngw, lane);
        for (int m = gw; m < TT; m += ngw) row_to_bf16_ssq(a.in[0] + (size_t)m * DM, XB + (size_t)m * DM, SSQX + (size_t)m * 16, lane);
        for (int m = gw; m < MROWS; m += ngw) row_to_bf16_ssq(a.in[1] + (size_t)m * DM, MEMB + (size_t)m * DM, SSQM + (size_t)m * 16, lane);
    }
    grid.sync();

#pragma unroll 1
    for (int l = 0; l < 4; ++l) {
        unsigned char* slot = ws + WS_WSLOT + (size_t)(l & 1) * SLOT_BYTES;
        const bf16_t* WIN = (const bf16_t*)(slot + SL_WIN); const bf16_t* WO = (const bf16_t*)(slot + SL_WO); const bf16_t* WGU = (const bf16_t*)(slot + SL_WGU); const bf16_t* WD = (const bf16_t*)(slot + SL_WD);
        const int pitch = (l < 2) ? PA : PB;
        if (l == 0) {
            pg8::Gemm g{MEMB, MKVW, MROWS, 2048, DM, DM}; pg8::StaticOrder S; S.init(MROWS, 2048, G, bx);
            pg8::EpiMKV E{SSQM, MK, MVT};
            pg8::gemm_phase<pg8::EpiMKV, pg8::StaticOrder, true>(lds, g, S, E);
        }
        {
            const int N = (l == 3) ? 1024 : 2560;
            pg8::Gemm g{XB, WIN, TT, N, DM, DM}; pg8::StaticOrder S; S.init(TT, N, G, bx);
            pg8::EpiProj E{SSQX, PACT, pitch, (l < 2) ? 10 : 4, KSH, MAINW, (l < 2) ? 0 : 3, VT, 12, MAINW};
            pg8::gemm_phase<pg8::EpiProj, pg8::StaticOrder, true>(lds, g, S, E);
        }
        grid.sync();
        {
            int tid2 = threadIdx.x; asm volatile("" : "+v"(tid2)); const int lane2 = tid2 & 63, gtid2 = bx * (NWAVES * 64) + tid2;
            if (l < 2) conv_items(PACT, a.in[4] + (size_t)l * 3 * MAINW, gtid2, nthreads);
            else for (int it = gw; it < NB * NHSB * 128; it += ngw) sb_attn_item(PACT, KSH, VT, it, lane2);
            for (int it = gw; it < NB * NHM * 128; it += ngw) mem_attn_item(PACT, pitch, MK + (size_t)l * MROWS * 256, MVT + (size_t)l * MROWS * 256, it, lane2);
            if (l == 1 || l == 2) { int base = 0; convert_layer(a, l + 1, base, scr, gw, ngw, lane2); }
        }
        grid.sync();
        {
            pg8::Gemm g{PACT, WO, TT, DM, DM, pitch}; pg8::StaticOrder S; S.init(TT, DM, G, bx);
            pg8::EpiRes E{(l == 0) ? a.in[0] : (const float*)X, X, XB, SSQX};
            pg8::gemm_phase<pg8::EpiRes, pg8::StaticOrder, true>(lds, g, S, E);
        }
        grid.sync();
        {
            pg8::Gemm g{XB, WGU, TT, 2 * FF, DM, DM}; pg8::StaticOrder S; S.init(TT, 2 * FF, G, bx);
            pg8::EpiSwiGLU E{SSQX, PACT, FF};
            pg8::gemm_phase<pg8::EpiSwiGLU, pg8::StaticOrder, true>(lds, g, S, E);
        }
        grid.sync();
        {
            pg8::Gemm g{PACT, WD, TT, DM, FF, FF}; pg8::StaticOrder S; S.init(TT, DM, G, bx);
            pg8::EpiRes E{X, X, XB, SSQX};
            pg8::gemm_phase<pg8::EpiRes, pg8::StaticOrder, true>(lds, g, S, E);
        }
        grid.sync();
    }
    for (int m = gw; m < TT; m += ngw) final_row(X + (size_t)m * DM, a.in[15], lane);
}

extern "C" void kernel_launch(void* const* d_in, const int* in_sizes, int n_in, void* d_out, int out_size, void* d_ws, size_t ws_size, hipStream_t stream) {
    static int grid = 0;
    if (grid == 0) {
        if (n_in != 16 || out_size != TT * DM || ws_size < WS_END) { fprintf(stderr, "kernel_launch: unexpected shapes (n_in %d, out %d, ws %zu)\n", n_in, out_size, ws_size); grid = -1; return; }
        int dev = 0, cus = 0, per_cu = 0;
        hipGetDevice(&dev); hipDeviceGetAttribute(&cus, hipDeviceAttributeMultiprocessorCount, dev);
        hipFuncSetAttribute((const void*)fwd_megakernel, hipFuncAttributeMaxDynamicSharedMemorySize, LDS_BYTES);
        hipOccupancyMaxActiveBlocksPerMultiprocessor(&per_cu, (const void*)fwd_megakernel, NWAVES * 64, LDS_BYTES);
        (void)hipGetLastError();
        if (per_cu < 1) per_cu = 1;
        grid = cus;
    }
    if (grid < 0) return;
    Args a{};
    for (int i = 0; i < 16; ++i) a.in[i] = (const float*)d_in[i];
    a.out = (float*)d_out; a.ws = (unsigned char*)d_ws;
    void* args[] = {&a};
    hipError_t e = hipLaunchCooperativeKernel((const void*)fwd_megakernel, dim3(grid), dim3(NWAVES * 64), args, LDS_BYTES, stream);
    if (e != hipSuccess) fprintf(stderr, "cooperative launch failed: %s (grid %d)\n", hipGetErrorString(e), grid);
}
```

```cpp
#include <hip/hip_runtime.h>
#include <hip/hip_cooperative_groups.h>
#include <cstdio>
#include <cstdint>
namespace cg = cooperative_groups;

#define LAS __attribute__((address_space(3)))
typedef unsigned short bf16_t;
typedef short bf16x8 __attribute__((ext_vector_type(8)));
typedef short s16x4 __attribute__((ext_vector_type(4)));
typedef float f32x4 __attribute__((ext_vector_type(4)));
typedef float f32x16 __attribute__((ext_vector_type(16)));
typedef unsigned u32x4 __attribute__((ext_vector_type(4)));
typedef unsigned u32x2 __attribute__((ext_vector_type(2)));

constexpr int SEQ = 4096, NB = 4, TT = NB * SEQ, DM = 1024, NMEM = 256, MROWS = NB * NMEM, FF = 2816, MAINW = 768, MEMW = 256, NHSB = 12, NHM = 4;
constexpr int PA = 2560;
constexpr int PB = 1024;
constexpr float EPS = 1e-6f, LOG2E = 1.4426950408889634f, LN2 = 0.6931471805599453f;

constexpr size_t MiB = 1u << 20;
constexpr size_t WS_CTL = 0, CTL_ZERO_BYTES = 65536;
constexpr size_t WS_SSQX = 1 * MiB;
constexpr size_t WS_SSQM = 2 * MiB;
constexpr size_t WS_MEMB = 3 * MiB;
constexpr size_t WS_MK = 5 * MiB;
constexpr size_t WS_MVT = 7 * MiB;
constexpr size_t WS_MKVW = 9 * MiB;
constexpr size_t WS_WSLOT = 13 * MiB, SLOT_BYTES = 24 * MiB;
constexpr size_t SL_WIN = 0, SL_WO = 5 * MiB, SL_WGU = 7 * MiB, SL_WD = 18 * MiB;
constexpr size_t WS_XB = 61 * MiB;
constexpr size_t WS_KSH = 93 * MiB;
constexpr size_t WS_VT = 117 * MiB;
constexpr size_t WS_PACT = 141 * MiB;
constexpr size_t WS_END = 229 * MiB;

constexpr int NWAVES = 8, LDS_BYTES = 147456;

namespace pg8 {
constexpr int BM = 256, BK = 64, HALF = 128, HTB = HALF * BK * 2, STAGE_BYTES = 8 * HTB, NXCD = 8, WGM = 8;
__host__ __device__ __forceinline__ int lds_byte(int r, int c) { const int st = (r >> 4) * 2 + (c >> 5), rr = r & 15, cc = c & 31, ob = rr * 64 + cc * 2; return st * 1024 + (ob ^ (((ob >> 9) & 1) << 5)); }
__host__ __device__ __forceinline__ void stage_rc(int b, int& R, int& C) { const int st = b / 1024, sb = b % 1024, swz = sb ^ (((sb >> 9) & 1) << 5); R = (st >> 1) * 16 + swz / 64; C = (st & 1) * 32 + (swz % 64) / 2; }
__host__ __device__ __forceinline__ int perm32(int rho) { const int n = rho >> 4, i = rho & 15; return 8 * (i >> 2) + 4 * n + (i & 3); }

struct Unit { int pm, pn; };
struct Gemm { const bf16_t* A; const bf16_t* Bt; int M, N, K, lda; };

struct StaticOrder {
    int nM, nN, nwg, G, c;
    __host__ __device__ void init(int M, int N, int G_, int c_) { nM = M / BM; nN = N / BM; nwg = nM * nN; G = G_; c = c_; }
    __host__ __device__ bool next(int i, Unit& u) const {
        const long L = (long)i * G + c; if (L >= nwg) return false;
        int wgid = (int)L; { const int q = nwg / NXCD, r = nwg % NXCD, xcd = wgid % NXCD, off = wgid / NXCD; wgid = (xcd < r ? xcd * (q + 1) : r * (q + 1) + (xcd - r) * q) + off; }
        const int nig = WGM * nN, gid = wgid / nig, fm = gid * WGM, gsz = (nM - fm) < WGM ? (nM - fm) : WGM;
        u.pm = fm + ((wgid % nig) % gsz); u.pn = (wgid % nig) / gsz; return true;
    }
};

__device__ __forceinline__ unsigned cvt_pk_bf16(float lo, float hi) { unsigned r; asm volatile("v_cvt_pk_bf16_f32 %0, %1, %2" : "=v"(r) : "v"(lo), "v"(hi)); return r; }

__device__ __forceinline__ float row_rs(const float* ssq, int row, int fq) {
    const f32x4 p = *(const f32x4*)(ssq + (size_t)row * 16 + 4 * fq);
    float s = (p[0] + p[1]) + (p[2] + p[3]);
    s += __shfl_xor(s, 16); s += __shfl_xor(s, 32);
    return __builtin_amdgcn_rsqf(s * (1.0f / 1024.0f) + EPS);
}
__device__ __forceinline__ void store_tile_normal(const f32x4 (&acc)[2][2][4][2], const float (&rs)[2][4], bf16_t* base, int ld, int row0, int col0) {
#pragma unroll
    for (int ai = 0; ai < 2; ++ai)
#pragma unroll
        for (int m = 0; m < 4; ++m) { bf16_t* rowp = base + (size_t)(row0 + ai * HALF + m * 16) * ld + col0; const float s = rs[ai][m];
#pragma unroll
            for (int bj = 0; bj < 2; ++bj) { const f32x4 v0 = acc[ai][bj][m][0] * s, v1 = acc[ai][bj][m][1] * s;
                u32x4 w; w.x = cvt_pk_bf16(v0[0], v0[1]); w.y = cvt_pk_bf16(v0[2], v0[3]); w.z = cvt_pk_bf16(v1[0], v1[1]); w.w = cvt_pk_bf16(v1[2], v1[3]);
                *(u32x4*)(rowp + bj * HALF) = w; } }
}
__device__ __forceinline__ void store_tile_trans(const f32x4 (&acc)[2][2][4][2], const float (&rs)[2][4], bf16_t* OT, int sh, int nct, int row0, int col0) {
#pragma unroll
    for (int ai = 0; ai < 2; ++ai)
#pragma unroll
        for (int m = 0; m < 4; ++m) { const int row = row0 + ai * HALF + m * 16; const float s = rs[ai][m];
            const size_t rb = (size_t)(row >> sh) * nct; const int rr = row & ((1 << sh) - 1);
#pragma unroll
            for (int bj = 0; bj < 2; ++bj)
#pragma unroll
                for (int n = 0; n < 2; ++n) { const f32x4 v = acc[ai][bj][m][n] * s; const unsigned w0 = cvt_pk_bf16(v[0], v[1]), w1 = cvt_pk_bf16(v[2], v[3]);
                    const int c = col0 + bj * HALF + 4 * n;
                    OT[((rb + c + 0) << sh) + rr] = (bf16_t)(w0 & 0xffffu); OT[((rb + c + 1) << sh) + rr] = (bf16_t)(w0 >> 16);
                    OT[((rb + c + 2) << sh) + rr] = (bf16_t)(w1 & 0xffffu); OT[((rb + c + 3) << sh) + rr] = (bf16_t)(w1 >> 16); } }
}
struct EpiProj {
    static constexpr bool PERM = true;
    const float* ssq; bf16_t* O0; int ld0, nt0; bf16_t* O1; int ld1, nt1; bf16_t* OT; int sh, nct;
    __device__ __forceinline__ void operator()(const f32x4 (&acc)[2][2][4][2], const Unit& u, int wr, int wc, int fr, int fq) const {
        const int row0 = u.pm * BM + wr * 64 + fr; float rs[2][4];
#pragma unroll
        for (int ai = 0; ai < 2; ++ai)
#pragma unroll
            for (int m = 0; m < 4; ++m) rs[ai][m] = row_rs(ssq, row0 + ai * HALF + m * 16, fq);
        const int cw = wc * 32 + 8 * fq;
        if (u.pn < nt0) store_tile_normal(acc, rs, O0, ld0, row0, u.pn * BM + cw);
        else if (u.pn < nt0 + nt1) store_tile_normal(acc, rs, O1, ld1, row0, (u.pn - nt0) * BM + cw);
        else store_tile_trans(acc, rs, OT, sh, nct, row0, (u.pn - nt0 - nt1) * BM + cw);
    }
};
struct EpiMKV {
    static constexpr bool PERM = true;
    const float* ssq; bf16_t* MK; bf16_t* MVT;
    __device__ __forceinline__ void operator()(const f32x4 (&acc)[2][2][4][2], const Unit& u, int wr, int wc, int fr, int fq) const {
        const int row0 = u.pm * BM + wr * 64 + fr; float rs[2][4];
#pragma unroll
        for (int ai = 0; ai < 2; ++ai)
#pragma unroll
            for (int m = 0; m < 4; ++m) rs[ai][m] = row_rs(ssq, row0 + ai * HALF + m * 16, fq);
        const int cw = wc * 32 + 8 * fq, l = u.pn >> 1;
        if ((u.pn & 1) == 0) store_tile_normal(acc, rs, MK + (size_t)l * MROWS * 256, 256, row0, cw);
        else store_tile_trans(acc, rs, MVT + (size_t)l * MROWS * 256, 8, 256, row0, cw);
    }
};
struct EpiSwiGLU {
    static constexpr bool PERM = true;
    const float* ssq; bf16_t* O; int ldc;
    __device__ __forceinline__ void operator()(const f32x4 (&acc)[2][2][4][2], const Unit& u, int wr, int wc, int fr, int fq) const {
        const int row0 = u.pm * BM + wr * 64 + fr, col0 = u.pn * HALF + wc * 32 + 8 * fq;
#pragma unroll
        for (int ai = 0; ai < 2; ++ai)
#pragma unroll
            for (int m = 0; m < 4; ++m) { const int row = row0 + ai * HALF + m * 16; const float s = row_rs(ssq, row, fq);
                float o[8];
#pragma unroll
                for (int n = 0; n < 2; ++n)
#pragma unroll
                    for (int i = 0; i < 4; ++i) { const float g = acc[ai][0][m][n][i] * s, up = acc[ai][1][m][n][i] * s;
                        o[4 * n + i] = g * __builtin_amdgcn_rcpf(1.0f + __builtin_amdgcn_exp2f(-g * LOG2E)) * up; }
                u32x4 w; w.x = cvt_pk_bf16(o[0], o[1]); w.y = cvt_pk_bf16(o[2], o[3]); w.z = cvt_pk_bf16(o[4], o[5]); w.w = cvt_pk_bf16(o[6], o[7]);
                *(u32x4*)(O + (size_t)row * ldc + col0) = w; }
    }
};
struct EpiRes {
    static constexpr bool PERM = true;
    const float* base; float* out; bf16_t* xb; float* ssq;
    __device__ __forceinline__ void operator()(const f32x4 (&acc)[2][2][4][2], const Unit& u, int wr, int wc, int fr, int fq) const {
        const int row0 = u.pm * BM + wr * 64 + fr, col0 = u.pn * BM + wc * 32 + 8 * fq;
#pragma unroll
        for (int ai = 0; ai < 2; ++ai)
#pragma unroll
            for (int m = 0; m < 4; ++m) { const int row = row0 + ai * HALF + m * 16; const size_t off = (size_t)row * DM + col0; float sq = 0.f;
#pragma unroll
                for (int bj = 0; bj < 2; ++bj) { const f32x4 b0 = *(const f32x4*)(base + off + bj * HALF), b1 = *(const f32x4*)(base + off + bj * HALF + 4);
                    const f32x4 x0 = b0 + acc[ai][bj][m][0], x1 = b1 + acc[ai][bj][m][1];
                    *(f32x4*)(out + off + bj * HALF) = x0; *(f32x4*)(out + off + bj * HALF + 4) = x1;
                    u32x4 w; w.x = cvt_pk_bf16(x0[0], x0[1]); w.y = cvt_pk_bf16(x0[2], x0[3]); w.z = cvt_pk_bf16(x1[0], x1[1]); w.w = cvt_pk_bf16(x1[2], x1[3]);
                    *(u32x4*)(xb + off + bj * HALF) = w;
                    sq += (x0[0] * x0[0] + x0[1] * x0[1]) + (x0[2] * x0[2] + x0[3] * x0[3]) + (x1[0] * x1[0] + x1[1] * x1[1]) + (x1[2] * x1[2] + x1[3] * x1[3]); }
                sq += __shfl_xor(sq, 16); sq += __shfl_xor(sq, 32);
                if (fq == 0) ssq[(size_t)row * 16 + u.pn * 4 + wc] = sq; }
    }
};

template <class Epi, class Sched, bool ALIGN_EPI>
__device__ __forceinline__ void gemm_phase(LAS unsigned char* lds, const Gemm g, const Sched& S, const Epi& E) {
    int tid = threadIdx.x; asm volatile("" : "+v"(tid));
    const int wid = __builtin_amdgcn_readfirstlane(tid >> 6), lane = tid & 63, wr = wid >> 2, wc = wid & 3, fr = lane & 15, fq = lane >> 4;
    const int K = g.K, nt = K / BK;
    unsigned voffA[2], voffB[2];
#pragma unroll
    for (int i = 0; i < 2; ++i) { int R, C; stage_rc(tid * 16 + i * 8192, R, C); const int Rb = Epi::PERM ? ((R & ~31) + perm32(R & 31)) : R;
        voffA[i] = (unsigned)(R * g.lda + C) * 2u; voffB[i] = (unsigned)(Rb * K + C) * 2u; }
    const size_t kstep = (size_t)(BK * 2);
    const size_t hstepA = (size_t)HALF * g.lda * 2, hstepB = (size_t)HALF * K * 2;
    const size_t tstepA = 2 * hstepA, tstepB = 2 * hstepB;
    const unsigned ldsw = (unsigned)wid * 1024u;
    const int aoff = lds_byte(wr * 64 + fr, fq * 8), boff = lds_byte(wc * 32 + fr, fq * 8);
#define PG8_SA(b, h) (((b) * 2 + (h)) * HTB)
#define PG8_SB(b, h) ((4 + (b) * 2 + (h)) * HTB)
#define PG8_STAGE(bufoff, gbase, voff) do { _Pragma("unroll") for (int _i = 0; _i < 2; ++_i) \
        __builtin_amdgcn_global_load_lds((const unsigned*)((const char*)(gbase) + (voff)[_i]), (LAS unsigned*)(lds + (bufoff) + ldsw + _i * 8192), 16, 0, 0); } while (0)
#define PG8_LDA(dst, b, h) do { _Pragma("unroll") for (int m = 0; m < 4; ++m) _Pragma("unroll") for (int k = 0; k < 2; ++k) dst[m][k] = *(const LAS bf16x8*)(lds + PG8_SA(b, h) + aoff + m * 2048 + k * 1024); } while (0)
#define PG8_LDB(dst, b, h) do { _Pragma("unroll") for (int n = 0; n < 2; ++n) _Pragma("unroll") for (int k = 0; k < 2; ++k) dst[n][k] = *(const LAS bf16x8*)(lds + PG8_SB(b, h) + boff + n * 2048 + k * 1024); } while (0)
#define PG8_MMA(ai, bj, At, Bt) do { __builtin_amdgcn_s_setprio(1); _Pragma("unroll") for (int m = 0; m < 4; ++m) _Pragma("unroll") for (int n = 0; n < 2; ++n) _Pragma("unroll") for (int k = 0; k < 2; ++k) \
        acc[ai][bj][m][n] = __builtin_amdgcn_mfma_f32_16x16x32_bf16(Bt[n][k], At[m][k], acc[ai][bj][m][n], 0, 0, 0); __builtin_amdgcn_s_setprio(0); } while (0)
#define PG8_WAIT_V(n) asm volatile("s_waitcnt vmcnt(" #n ")" ::: "memory")
#define PG8_WAIT_L(n) asm volatile("s_waitcnt lgkmcnt(" #n ")" ::: "memory")
#define PG8_BAR __builtin_amdgcn_s_barrier()
#define PG8_SCHED __builtin_amdgcn_sched_barrier(0)
    Unit cur, nxt; int ui = 0;
    if (!S.next(0, cur)) return;
    f32x4 acc[2][2][4][2];
#pragma unroll
    for (int a = 0; a < 2; ++a)
#pragma unroll
        for (int b = 0; b < 2; ++b)
#pragma unroll
            for (int m = 0; m < 4; ++m)
#pragma unroll
                for (int n = 0; n < 2; ++n) acc[a][b][m][n] = (f32x4){0.f, 0.f, 0.f, 0.f};
    bf16x8 At[4][2], B0[2][2], B1[2][2];
    const char* cA = (const char*)g.A + (size_t)cur.pm * tstepA; const char* cB = (const char*)g.Bt + (size_t)cur.pn * tstepB;
    PG8_STAGE(PG8_SB(0, 0), cB, voffB); PG8_STAGE(PG8_SB(0, 1), cB + hstepB, voffB); PG8_STAGE(PG8_SA(0, 0), cA, voffA); PG8_STAGE(PG8_SA(0, 1), cA + hstepA, voffA);
    if (wr == 1) PG8_BAR;
    PG8_WAIT_V(2); PG8_BAR;
    PG8_STAGE(PG8_SB(1, 0), cB + kstep, voffB); PG8_STAGE(PG8_SA(1, 0), cA + kstep, voffA); PG8_STAGE(PG8_SB(1, 1), cB + hstepB + kstep, voffB);
    PG8_WAIT_V(6); PG8_BAR;
    for (;;) {
        const bool has_next = S.next(ui + 1, nxt);
        const char* nA = has_next ? (const char*)g.A + (size_t)nxt.pm * tstepA : cA; const char* nB = has_next ? (const char*)g.Bt + (size_t)nxt.pn * tstepB : cB;
        for (int t = 0; t < nt; t += 2) {
            const bool last = (t == nt - 2);
            const char* a1 = cA + (size_t)(t + 1) * kstep;
            const char* a2 = last ? nA : cA + (size_t)(t + 2) * kstep; const char* b2 = last ? nB : cB + (size_t)(t + 2) * kstep;
            const char* a3 = a2 + kstep; const char* b3 = b2 + kstep;
            PG8_LDB(B0, 0, 0); PG8_LDB(B1, 0, 1); PG8_SCHED; PG8_LDA(At, 0, 0); PG8_STAGE(PG8_SA(1, 1), a1 + hstepA, voffA);
            PG8_WAIT_V(8); PG8_WAIT_L(0); PG8_BAR; PG8_MMA(0, 0, At, B0); PG8_MMA(0, 1, At, B1); PG8_BAR; PG8_SCHED;
            PG8_LDA(At, 0, 1); PG8_STAGE(PG8_SB(0, 0), b2, voffB); PG8_STAGE(PG8_SB(0, 1), b2 + hstepB, voffB); PG8_STAGE(PG8_SA(0, 0), a2, voffA);
            PG8_WAIT_V(8); PG8_WAIT_L(0); PG8_BAR; PG8_MMA(1, 0, At, B0); PG8_MMA(1, 1, At, B1); PG8_BAR; PG8_SCHED;
            PG8_LDB(B0, 1, 0); PG8_LDB(B1, 1, 1); PG8_SCHED; PG8_LDA(At, 1, 0); PG8_STAGE(PG8_SA(0, 1), a2 + hstepA, voffA);
            PG8_WAIT_V(8); PG8_WAIT_L(0); PG8_BAR; PG8_MMA(0, 0, At, B0); PG8_MMA(0, 1, At, B1); PG8_BAR; PG8_SCHED;
            PG8_LDA(At, 1, 1); PG8_STAGE(PG8_SB(1, 0), b3, voffB); PG8_STAGE(PG8_SB(1, 1), b3 + hstepB, voffB); PG8_STAGE(PG8_SA(1, 0), a3, voffA);
            PG8_WAIT_V(8); PG8_WAIT_L(0); PG8_BAR; PG8_MMA(1, 0, At, B0); PG8_MMA(1, 1, At, B1); PG8_BAR; PG8_SCHED;
        }
        if constexpr (ALIGN_EPI) { if (wr == 0) PG8_BAR; }
        E(acc, cur, wr, wc, fr, fq);
        if (!has_next) break;
#pragma unroll
        for (int a = 0; a < 2; ++a)
#pragma unroll
            for (int b = 0; b < 2; ++b)
#pragma unroll
                for (int m = 0; m < 4; ++m)
#pragma unroll
                    for (int n = 0; n < 2; ++n) acc[a][b][m][n] = (f32x4){0.f, 0.f, 0.f, 0.f};
        cur = nxt; cA = nA; cB = nB; ++ui;
        if constexpr (ALIGN_EPI) { if (wr == 1) PG8_BAR; }
    }
    PG8_WAIT_V(0);
    if constexpr (!ALIGN_EPI) { if (wr == 0) PG8_BAR; }
    PG8_BAR;
#undef PG8_SA
#undef PG8_SB
#undef PG8_STAGE
#undef PG8_LDA
#undef PG8_LDB
#undef PG8_MMA
#undef PG8_WAIT_V
#undef PG8_WAIT_L
#undef PG8_BAR
#undef PG8_SCHED
}
}

__device__ __forceinline__ float wave_sum(float v) {
#pragma unroll
    for (int o = 1; o < 64; o <<= 1) v += __shfl_xor(v, o);
    return v;
}
__device__ __forceinline__ unsigned pk2(float lo, float hi) { return pg8::cvt_pk_bf16(lo, hi); }
__device__ __forceinline__ float bf_lo(unsigned w) { return __uint_as_float(w << 16); }
__device__ __forceinline__ float bf_hi(unsigned w) { return __uint_as_float(w & 0xffff0000u); }
__device__ __forceinline__ int crow(int r, int hi) { return (r & 3) + 8 * (r >> 2) + 4 * hi; }

__device__ __forceinline__ void tr_item(const float* W, int N, int k0, int n0, const float* gain, float scale, bf16_t* WT, int Kd, int drow0, LAS float* scr, int lane) {
#pragma unroll 8
    for (int i = 0; i < 32; ++i) { const int kk = 2 * i + (lane >> 5); const float g = gain ? gain[k0 + kk] * scale : scale;
        scr[kk * 33 + (lane & 31)] = W[(size_t)(k0 + kk) * N + n0 + (lane & 31)] * g; }
    asm volatile("s_waitcnt lgkmcnt(0)" ::: "memory");
    const int c = lane & 7;
#pragma unroll
    for (int j = 0; j < 4; ++j) { const int n = (lane >> 3) + 8 * j; const LAS float* s = scr + (8 * c) * 33 + n;
        u32x4 o; o.x = pk2(s[0 * 33], s[1 * 33]); o.y = pk2(s[2 * 33], s[3 * 33]); o.z = pk2(s[4 * 33], s[5 * 33]); o.w = pk2(s[6 * 33], s[7 * 33]);
        *(u32x4*)(WT + (size_t)(drow0 + n) * Kd + k0 + 8 * c) = o; }
    asm volatile("s_waitcnt lgkmcnt(0)" ::: "memory");
}
enum { MAP_ID = 0, MAP_AIN = 1, MAP_GATE = 2, MAP_UP = 3 };
__device__ __forceinline__ void conv_job(int& base, const float* W, int K, int N, const float* gain, float scale, bf16_t* WT, int Kd, int map, int row_off, LAS float* scr, int gw, int ngw, int lane) {
    const int nblk = N / 32, nitems = (K / 64) * nblk;
    int first = (gw - (base % ngw)); if (first < 0) first += ngw;
    for (int it = first; it < nitems; it += ngw) {
        const int kb = it / nblk, nb = it % nblk, n0 = 32 * nb; int drow0 = row_off + n0; float sc = scale;
        if (map == MAP_AIN) { if (n0 < 768) drow0 = n0; else if (n0 < 1536) drow0 = n0 - 768 + 1024; else if (n0 < 2304) drow0 = n0 - 1536 + 1792; else { drow0 = n0 - 2304 + 768; sc = 0.125f; } }
        else if (map == MAP_GATE) drow0 = (n0 >> 7) * 256 + (n0 & 127);
        else if (map == MAP_UP) drow0 = (n0 >> 7) * 256 + 128 + (n0 & 127);
        tr_item(W, N, 64 * kb, n0, gain, sc, WT, Kd, drow0, scr, lane);
    }
    base += nitems;
}

struct Args { const float* in[16]; float* out; unsigned char* ws; };

__device__ __forceinline__ void convert_layer(const Args& a, int l, int& base, LAS float* scr, int gw, int ngw, int lane) {
    unsigned char* slot = a.ws + WS_WSLOT + (size_t)(l & 1) * SLOT_BYTES;
    bf16_t* WIN = (bf16_t*)(slot + SL_WIN); bf16_t* WO = (bf16_t*)(slot + SL_WO); bf16_t* WGU = (bf16_t*)(slot + SL_WGU); bf16_t* WD = (bf16_t*)(slot + SL_WD);
    const float* mixg = a.in[2] + (size_t)l * DM; const float* ffng = a.in[10] + (size_t)l * DM;
    if (l < 2) conv_job(base, a.in[3] + (size_t)l * DM * PA, DM, PA, mixg, 1.0f, WIN, DM, MAP_AIN, 0, scr, gw, ngw, lane);
    else {
        conv_job(base, a.in[5] + (size_t)(l - 2) * DM * DM, DM, DM, mixg, 0.125f, WIN, DM, MAP_ID, 0, scr, gw, ngw, lane);
        if (l == 2) conv_job(base, a.in[7], DM, 2 * MAINW, a.in[6], 1.0f, WIN, DM, MAP_ID, DM, scr, gw, ngw, lane);
    }
    conv_job(base, a.in[9] + (size_t)l * DM * DM, DM, DM, nullptr, 1.0f, WO, DM, MAP_ID, 0, scr, gw, ngw, lane);
    conv_job(base, a.in[11] + (size_t)l * DM * FF, DM, FF, ffng, 1.0f, WGU, DM, MAP_GATE, 0, scr, gw, ngw, lane);
    conv_job(base, a.in[12] + (size_t)l * DM * FF, DM, FF, ffng, 1.0f, WGU, DM, MAP_UP, 0, scr, gw, ngw, lane);
    conv_job(base, a.in[13] + (size_t)l * FF * DM, FF, DM, nullptr, 1.0f, WD, FF, MAP_ID, 0, scr, gw, ngw, lane);
}

__device__ __forceinline__ void row_to_bf16_ssq(const float* xrow, bf16_t* orow, float* ssq16, int lane) {
    const f32x4* xr = (const f32x4*)xrow + lane; f32x4 v[4]; float s = 0.f;
#pragma unroll
    for (int j = 0; j < 4; ++j) { v[j] = xr[64 * j]; s += (v[j][0] * v[j][0] + v[j][1] * v[j][1]) + (v[j][2] * v[j][2] + v[j][3] * v[j][3]); }
    s = wave_sum(s);
    u32x2* o8 = (u32x2*)orow + lane;
#pragma unroll
    for (int j = 0; j < 4; ++j) { u32x2 w; w.x = pk2(v[j][0], v[j][1]); w.y = pk2(v[j][2], v[j][3]); o8[64 * j] = w; }
    if (lane < 4) *(f32x4*)(ssq16 + 4 * lane) = (f32x4){lane == 0 ? s : 0.f, 0.f, 0.f, 0.f};
}
__device__ __forceinline__ void final_row(float* xrow, const float* g, int lane) {
    f32x4* xr = (f32x4*)xrow + lane; const f32x4* gr = (const f32x4*)g + lane; f32x4 v[4]; float s = 0.f;
#pragma unroll
    for (int j = 0; j < 4; ++j) { v[j] = xr[64 * j]; s += (v[j][0] * v[j][0] + v[j][1] * v[j][1]) + (v[j][2] * v[j][2] + v[j][3] * v[j][3]); }
    s = wave_sum(s); const float rs = 1.0f / sqrtf(s * (1.0f / 1024.0f) + EPS);
#pragma unroll
    for (int j = 0; j < 4; ++j) xr[64 * j] = v[j] * rs * gr[64 * j];
}

__device__ __forceinline__ void conv_items(bf16_t* P, const float* cw, int gtid, int nthreads) {
    for (int it = gtid; it < (TT / 16) * 96; it += nthreads) {
        const int cgp = it % 96, ch = it / 96, row0 = ch * 16, c0 = cgp * 8, t0 = row0 & (SEQ - 1);
        float w0[8], w1[8], w2[8], p2[8], p1[8];
#pragma unroll
        for (int i = 0; i < 8; ++i) { w0[i] = cw[c0 + i]; w1[i] = cw[MAINW + c0 + i]; w2[i] = cw[2 * MAINW + c0 + i]; p2[i] = 0.f; p1[i] = 0.f; }
        if (t0 >= 2) {
            const bf16_t* r2 = P + (size_t)(row0 - 2) * PA; const bf16_t* r1 = P + (size_t)(row0 - 1) * PA;
            const u32x4 g2 = *(const u32x4*)(r2 + 1024 + c0), u2 = *(const u32x4*)(r2 + 1792 + c0), g1 = *(const u32x4*)(r1 + 1024 + c0), u1 = *(const u32x4*)(r1 + 1792 + c0);
#pragma unroll
            for (int i = 0; i < 4; ++i) { p2[2 * i] = bf_lo(g2[i]) * bf_lo(u2[i]); p2[2 * i + 1] = bf_hi(g2[i]) * bf_hi(u2[i]); p1[2 * i] = bf_lo(g1[i]) * bf_lo(u1[i]); p1[2 * i + 1] = bf_hi(g1[i]) * bf_hi(u1[i]); }
        }
#pragma unroll 4
        for (int i = 0; i < 16; ++i) {
            bf16_t* r = P + (size_t)(row0 + i) * PA;
            const u32x4 gg = *(const u32x4*)(r + 1024 + c0), uu = *(const u32x4*)(r + 1792 + c0), bb = *(const u32x4*)(r + c0);
            float cu[8], y[8];
#pragma unroll
            for (int j = 0; j < 4; ++j) { cu[2 * j] = bf_lo(gg[j]) * bf_lo(uu[j]); cu[2 * j + 1] = bf_hi(gg[j]) * bf_hi(uu[j]); }
#pragma unroll
            for (int j = 0; j < 4; ++j) { y[2 * j] = bf_lo(bb[j]) * (w0[2 * j] * p2[2 * j] + w1[2 * j] * p1[2 * j] + w2[2 * j] * cu[2 * j]);
                y[2 * j + 1] = bf_hi(bb[j]) * (w0[2 * j + 1] * p2[2 * j + 1] + w1[2 * j + 1] * p1[2 * j + 1] + w2[2 * j + 1] * cu[2 * j + 1]); }
            u32x4 o; o.x = pk2(y[0], y[1]); o.y = pk2(y[2], y[3]); o.z = pk2(y[4], y[5]); o.w = pk2(y[6], y[7]);
            *(u32x4*)(r + c0) = o;
#pragma unroll
            for (int j = 0; j < 8; ++j) { p2[j] = p1[j]; p1[j] = cu[j]; }
        }
    }
}

__device__ __forceinline__ float half_max(float m) { auto rr = __builtin_amdgcn_permlane32_swap(__float_as_uint(m), __float_as_uint(m), false, false); return fmaxf(__uint_as_float(rr[0]), __uint_as_float(rr[1])); }
__device__ __forceinline__ bf16x8 pack8(const f32x16& p, int s) {
    u32x4 w; w.x = pk2(p[8 * s + 0], p[8 * s + 1]); w.y = pk2(p[8 * s + 2], p[8 * s + 3]); w.z = pk2(p[8 * s + 4], p[8 * s + 5]); w.w = pk2(p[8 * s + 6], p[8 * s + 7]);
    return __builtin_bit_cast(bf16x8, w);
}
__device__ __forceinline__ bf16x8 vfrag(const bf16_t* p) {
    const s16x4 lo = *(const s16x4*)p, hi = *(const s16x4*)(p + 8);
    return (bf16x8){lo[0], lo[1], lo[2], lo[3], hi[0], hi[1], hi[2], hi[3]};
}
__device__ __forceinline__ void store_o(bf16_t* qp, const f32x16& o0, const f32x16& o1, float sc, int hi) {
#pragma unroll
    for (int g = 0; g < 4; ++g) { u32x2 w; w.x = pk2(o0[4 * g] * sc, o0[4 * g + 1] * sc); w.y = pk2(o0[4 * g + 2] * sc, o0[4 * g + 3] * sc); *(u32x2*)(qp + 8 * g + 4 * hi) = w; }
#pragma unroll
    for (int g = 0; g < 4; ++g) { u32x2 w; w.x = pk2(o1[4 * g] * sc, o1[4 * g + 1] * sc); w.y = pk2(o1[4 * g + 2] * sc, o1[4 * g + 3] * sc); *(u32x2*)(qp + 32 + 8 * g + 4 * hi) = w; }
}

__device__ __forceinline__ void mem_attn_item(bf16_t* P, int pitch, const bf16_t* MK, const bf16_t* MVT, int item, int lane) {
    const int qb = item & 127, hm = (item >> 7) & 3, b = item >> 9, r32 = lane & 31, hi = lane >> 5;
    bf16_t* qp = P + (size_t)(b * SEQ + qb * 32 + r32) * pitch + MAINW + hm * 64;
    bf16x8 qf[4];
#pragma unroll
    for (int d0 = 0; d0 < 4; ++d0) qf[d0] = *(const bf16x8*)(qp + d0 * 16 + hi * 8);
    const bf16_t* kp = MK + (size_t)(b * NMEM + r32) * 256 + hm * 64 + hi * 8;
    f32x16 sc[8];
#pragma unroll
    for (int mt = 0; mt < 8; ++mt) { f32x16 z = {};
#pragma unroll
        for (int d0 = 0; d0 < 4; ++d0) { const bf16x8 kf = *(const bf16x8*)(kp + (size_t)mt * 32 * 256 + d0 * 16); z = __builtin_amdgcn_mfma_f32_32x32x16_bf16(kf, qf[d0], z, 0, 0, 0); }
        sc[mt] = z; }
    float mx = -INFINITY;
#pragma unroll
    for (int mt = 0; mt < 8; ++mt)
#pragma unroll
        for (int r = 0; r < 16; ++r) mx = fmaxf(mx, sc[mt][r]);
    mx = half_max(mx);
    float l = 0.f;
#pragma unroll
    for (int mt = 0; mt < 8; ++mt)
#pragma unroll
        for (int r = 0; r < 16; ++r) { const float e = __builtin_amdgcn_exp2f((sc[mt][r] - mx) * LOG2E); sc[mt][r] = e; l += e; }
    { auto rr = __builtin_amdgcn_permlane32_swap(__float_as_uint(l), __float_as_uint(l), false, false); l = __uint_as_float(rr[0]) + __uint_as_float(rr[1]); }
    f32x16 o0 = {}, o1 = {};
    const bf16_t* vp = MVT + (size_t)((b * NHM + hm) * 64 + r32) * NMEM + 4 * hi;
#pragma unroll
    for (int mt = 0; mt < 8; ++mt)
#pragma unroll
        for (int s = 0; s < 2; ++s) { const bf16x8 pf = pack8(sc[mt], s);
            o0 = __builtin_amdgcn_mfma_f32_32x32x16_bf16(vfrag(vp + mt * 32 + 16 * s), pf, o0, 0, 0, 0);
            o1 = __builtin_amdgcn_mfma_f32_32x32x16_bf16(vfrag(vp + 32 * NMEM + mt * 32 + 16 * s), pf, o1, 0, 0, 0); }
    store_o(qp, o0, o1, 1.0f / l, hi);
}

__device__ __forceinline__ void sb_attn_item(bf16_t* P, const bf16_t* Ksh, const bf16_t* VT, int item, int lane) {
    const int qb = item & 127, bh = item >> 7, h = bh % NHSB, b = bh / NHSB, r32 = lane & 31, hi = lane >> 5;
    bf16_t* qp = P + (size_t)(b * SEQ + qb * 32 + r32) * PB + h * 64;
    bf16x8 qf[4];
#pragma unroll
    for (int d0 = 0; d0 < 4; ++d0) qf[d0] = *(const bf16x8*)(qp + d0 * 16 + hi * 8);
    const bf16_t* kbase = Ksh + (size_t)(b * SEQ + r32) * MAINW + h * 64 + hi * 8;
    const bf16_t* vbase = VT + (size_t)((b * NHSB + h) * 64 + r32) * SEQ + 4 * hi;
    float C = 0.f; f32x16 o0 = {}, o1 = {};
    for (int kt = qb; kt >= 0; --kt) {
        const bf16_t* kp = kbase + (size_t)kt * 32 * MAINW;
        f32x16 z = {};
#pragma unroll
        for (int d0 = 0; d0 < 4; ++d0) { const bf16x8 kf = *(const bf16x8*)(kp + d0 * 16); z = __builtin_amdgcn_mfma_f32_32x32x16_bf16(kf, qf[d0], z, 0, 0, 0); }
        const bf16x8 v00 = vfrag(vbase + kt * 32), v01 = vfrag(vbase + kt * 32 + 16), v10 = vfrag(vbase + 32 * SEQ + kt * 32), v11 = vfrag(vbase + 32 * SEQ + kt * 32 + 16);
        const bool diag = (kt == qb);
        float ln[16], zl[16];
#pragma unroll
        for (int r = 0; r < 16; ++r) { const float zz = z[r], e = __builtin_amdgcn_exp2f(-fabsf(zz) * LOG2E), sp = fmaxf(zz, 0.f) + LN2 * __builtin_amdgcn_logf(1.0f + e);
            const bool valid = !diag || (crow(r, hi) < r32);
            ln[r] = valid ? -sp : 0.f; zl[r] = valid ? (zz - sp) : -INFINITY; }
        float G0[4], G1[4];
#pragma unroll
        for (int g = 0; g < 4; ++g) { const float gs = (ln[4 * g] + ln[4 * g + 1]) + (ln[4 * g + 2] + ln[4 * g + 3]);
            const float ot = __shfl_xor(gs, 32); G0[g] = hi ? ot : gs; G1[g] = hi ? gs : ot; }
        float R = C;
        f32x16 a;
#pragma unroll
        for (int g = 3; g >= 0; --g) {
            float tl = R + (hi == 0 ? G1[g] : 0.f);
            a[4 * g + 3] = __builtin_amdgcn_exp2f((zl[4 * g + 3] + tl) * LOG2E); tl += ln[4 * g + 3];
            a[4 * g + 2] = __builtin_amdgcn_exp2f((zl[4 * g + 2] + tl) * LOG2E); tl += ln[4 * g + 2];
            a[4 * g + 1] = __builtin_amdgcn_exp2f((zl[4 * g + 1] + tl) * LOG2E); tl += ln[4 * g + 1];
            a[4 * g + 0] = __builtin_amdgcn_exp2f((zl[4 * g + 0] + tl) * LOG2E);
            R += G0[g] + G1[g];
        }
        C = R;
        const bf16x8 p0 = pack8(a, 0), p1 = pack8(a, 1);
        o0 = __builtin_amdgcn_mfma_f32_32x32x16_bf16(v00, p0, o0, 0, 0, 0); o0 = __builtin_amdgcn_mfma_f32_32x32x16_bf16(v01, p1, o0, 0, 0, 0);
        o1 = __builtin_amdgcn_mfma_f32_32x32x16_bf16(v10, p0, o1, 0, 0, 0); o1 = __builtin_amdgcn_mfma_f32_32x32x16_bf16(v11, p1, o1, 0, 0, 0);
        if (__all(C < -110.0f)) break;
    }
    store_o(qp, o0, o1, 1.0f, hi);
}

#define XB_TMO      128
#define XB_XCNT(j)  (256  + 64 * (j))
#define XB_XSUB(j)  (1280 + 64 * (j))
#define XB_XGEN(j)  (2304 + 64 * (j))
#define XB_TOP      3328
#define XB_TOPGEN   3392
#define XCD_BAR_WORDS 3456
#define XB_SPIN_CAP (1u << 18)
__device__ __forceinline__ unsigned xb_ld(unsigned* p)              { return __hip_atomic_load(p, __ATOMIC_RELAXED, __HIP_MEMORY_SCOPE_AGENT); }
__device__ __forceinline__ unsigned xb_add(unsigned* p, unsigned v) { return __hip_atomic_fetch_add(p, v, __ATOMIC_RELAXED, __HIP_MEMORY_SCOPE_AGENT); }
__device__ __forceinline__ unsigned xb_xcc_id() { return (unsigned)__builtin_amdgcn_s_getreg((3 << 11) | 20) & 0xFu; }
#define XB_SPIN(cond, bar) do { unsigned _sp = 0; while (cond) { __builtin_amdgcn_s_sleep(1); \
    if ((++_sp & 255u) == 0u) { if (xb_ld(&(bar)[XB_TMO])) break; if (_sp > XB_SPIN_CAP) { atomicAdd(&(bar)[XB_TMO], 1u); break; } } } } while (0)
struct XcdBarrier { unsigned* bar; unsigned x; volatile LAS unsigned* st; };
__device__ __forceinline__ XcdBarrier xcd_barrier_post(unsigned* bar, volatile LAS unsigned* st) {
    XcdBarrier b; b.bar = bar; b.x = xb_xcc_id(); b.st = st;
    if (threadIdx.x == 0) (void)xb_add(&bar[XB_XCNT(b.x)], 1u);
    return b;
}
__device__ __forceinline__ void xcd_barrier_complete(unsigned* bar, unsigned x, unsigned& nloc, unsigned& nx) {
    const unsigned G = gridDim.x * gridDim.y * gridDim.z;
    unsigned sum, cnt, mine, sp = 0u;
    for (;;) {
        sum = 0u; cnt = 0u; mine = 0u;
#pragma unroll
        for (unsigned j = 0; j < 16; ++j) { const unsigned c = xb_ld(&bar[XB_XCNT(j)]); sum += c; cnt += (c > 0u) ? 1u : 0u; mine = (j == x) ? c : mine; }
        if (sum == G) break;
        __builtin_amdgcn_s_sleep(1);
        if ((++sp & 255u) == 0u) { if (xb_ld(&bar[XB_TMO])) break; if (sp > XB_SPIN_CAP) { atomicAdd(&bar[XB_TMO], 1u); break; } }
    }
    nloc = mine > 0u ? mine : 1u; nx = cnt > 0u ? cnt : 1u;
}
__device__ __forceinline__ void xcd_barrier(const XcdBarrier& b) {
    asm volatile("s_waitcnt vmcnt(0)" ::: "memory");
    __syncthreads();
    if (threadIdx.x == 0) {
        unsigned* bar = b.bar;
        __builtin_amdgcn_s_waitcnt(0);
        unsigned nloc = b.st[0], nx = b.st[1];
        if (nloc == 0u) { xcd_barrier_complete(bar, b.x, nloc, nx); b.st[0] = nloc; b.st[1] = nx; }
        const unsigned old = xb_add(&bar[XB_XSUB(b.x)], 1u);
        const unsigned gen = old / nloc;
        if (old + 1u == (gen + 1u) * nloc) {
            __builtin_amdgcn_fence(__ATOMIC_RELEASE, "agent");
            asm volatile("s_waitcnt vmcnt(0)" ::: "memory");
            const unsigned og = xb_add(&bar[XB_TOP], 1u);
            const unsigned tg = og / nx;
            if (og + 1u == (tg + 1u) * nx) xb_add(&bar[XB_TOPGEN], 1u);
            else XB_SPIN(xb_ld(&bar[XB_TOPGEN]) == tg, bar);
            __builtin_amdgcn_fence(__ATOMIC_ACQUIRE, "agent");
            xb_add(&bar[XB_XGEN(b.x)], 1u);
            asm volatile("s_waitcnt vmcnt(0)" ::: "memory");
        } else {
            XB_SPIN(xb_ld(&bar[XB_XGEN(b.x)]) == gen, bar);
            __builtin_amdgcn_fence(__ATOMIC_ACQUIRE, "agent");
            asm volatile("s_waitcnt vmcnt(0)" ::: "memory");
        }
    }
    __syncthreads();
}

__global__ void __launch_bounds__(NWAVES * 64, 2) fwd_megakernel(Args a) {
    extern __shared__ __attribute__((aligned(16))) unsigned char lds_raw[];
    cg::grid_group grid = cg::this_grid();
    LAS unsigned char* lds = (LAS unsigned char*)lds_raw;
    const int tid = threadIdx.x, lane = tid & 63, wave = __builtin_amdgcn_readfirstlane(tid >> 6);
    const int G = gridDim.x, bx = blockIdx.x;
    const int gw = bx * NWAVES + wave, ngw = G * NWAVES, gtid = bx * (NWAVES * 64) + tid, nthreads = G * NWAVES * 64;
    unsigned char* ws = a.ws;
    float* X = a.out;
    float* SSQX = (float*)(ws + WS_SSQX); float* SSQM = (float*)(ws + WS_SSQM);
    bf16_t* MEMB = (bf16_t*)(ws + WS_MEMB); bf16_t* MK = (bf16_t*)(ws + WS_MK); bf16_t* MVT = (bf16_t*)(ws + WS_MVT); bf16_t* MKVW = (bf16_t*)(ws + WS_MKVW);
    bf16_t* XB = (bf16_t*)(ws + WS_XB); bf16_t* KSH = (bf16_t*)(ws + WS_KSH); bf16_t* VT = (bf16_t*)(ws + WS_VT); bf16_t* PACT = (bf16_t*)(ws + WS_PACT);
    LAS float* scr = (LAS float*)(lds + wave * 16384);
    volatile LAS unsigned* MISC = (volatile LAS unsigned*)(lds + 131072 + 320);
    if (tid < 32) MISC[tid] = 0u;
    __syncthreads();
    const XcdBarrier bar = xcd_barrier_post((unsigned*)(ws + WS_CTL) + 4096, MISC + 8);

    {
        int base = 0;
#pragma unroll 1
        for (int l = 0; l < 4; ++l) conv_job(base, a.in[8] + (size_t)l * DM * 512, DM, 512, a.in[14], 1.0f, MKVW, DM, MAP_ID, l * 512, scr, gw, ngw, lane);
        convert_layer(a, 0, base, scr, gw, ngw, lane);
        convert_layer(a, 1, base, scr, gw, ngw, lane);
        for (int m = gw; m < TT; m += ngw) row_to_bf16_ssq(a.in[0] + (size_t)m * DM, XB + (size_t)m * DM, SSQX + (size_t)m * 16, lane);
        for (int m = gw; m < MROWS; m += ngw) row_to_bf16_ssq(a.in[1] + (size_t)m * DM, MEMB + (size_t)m * DM, SSQM + (size_t)m * 16, lane);
    }
    grid.sync();

#pragma unroll 1
    for (int l = 0; l < 4; ++l) {
        unsigned char* slot = ws + WS_WSLOT + (size_t)(l & 1) * SLOT_BYTES;
        const bf16_t* WIN = (const bf16_t*)(slot + SL_WIN); const bf16_t* WO = (const bf16_t*)(slot + SL_WO); const bf16_t* WGU = (const bf16_t*)(slot + SL_WGU); const bf16_t* WD = (const bf16_t*)(slot + SL_WD);
        const int pitch = (l < 2) ? PA : PB;
        if (l == 0) {
            pg8::Gemm g{MEMB, MKVW, MROWS, 2048, DM, DM}; pg8::StaticOrder S; S.init(MROWS, 2048, G, bx);
            pg8::EpiMKV E{SSQM, MK, MVT};
            pg8::gemm_phase<pg8::EpiMKV, pg8::StaticOrder, true>(lds, g, S, E);
        }
        {
            const int N = (l == 3) ? 1024 : 2560;
            pg8::Gemm g{XB, WIN, TT, N, DM, DM}; pg8::StaticOrder S; S.init(TT, N, G, bx);
            pg8::EpiProj E{SSQX, PACT, pitch, (l < 2) ? 10 : 4, KSH, MAINW, (l < 2) ? 0 : 3, VT, 12, MAINW};
            pg8::gemm_phase<pg8::EpiProj, pg8::StaticOrder, true>(lds, g, S, E);
        }
        xcd_barrier(bar);
        {
            int tid2 = threadIdx.x; asm volatile("" : "+v"(tid2)); const int lane2 = tid2 & 63, gtid2 = bx * (NWAVES * 64) + tid2;
            if (l < 2) conv_items(PACT, a.in[4] + (size_t)l * 3 * MAINW, gtid2, nthreads);
            else for (int it = gw; it < NB * NHSB * 128; it += ngw) sb_attn_item(PACT, KSH, VT, it, lane2);
            for (int it = gw; it < NB * NHM * 128; it += ngw) mem_attn_item(PACT, pitch, MK + (size_t)l * MROWS * 256, MVT + (size_t)l * MROWS * 256, it, lane2);
            if (l == 1 || l == 2) { int base = 0; convert_layer(a, l + 1, base, scr, gw, ngw, lane2); }
        }
        xcd_barrier(bar);
        {
            pg8::Gemm g{PACT, WO, TT, DM, DM, pitch}; pg8::StaticOrder S; S.init(TT, DM, G, bx);
            pg8::EpiRes E{(l == 0) ? a.in[0] : (const float*)X, X, XB, SSQX};
            pg8::gemm_phase<pg8::EpiRes, pg8::StaticOrder, true>(lds, g, S, E);
        }
        xcd_barrier(bar);
        {
            pg8::Gemm g{XB, WGU, TT, 2 * FF, DM, DM}; pg8::StaticOrder S; S.init(TT, 2 * FF, G, bx);
            pg8::EpiSwiGLU E{SSQX, PACT, FF};
            pg8::gemm_phase<pg8::EpiSwiGLU, pg8::StaticOrder, true>(lds, g, S, E);
        }
        xcd_barrier(bar);
        {
            pg8::Gemm g{PACT, WD, TT, DM, FF, FF}; pg8::StaticOrder S; S.init(TT, DM, G, bx);
            pg8::EpiRes E{X, X, XB, SSQX};
            pg8::gemm_phase<pg8::EpiRes, pg8::StaticOrder, true>(lds, g, S, E);
        }
        xcd_barrier(bar);
    }
    for (int m = gw; m < TT; m += ngw) final_row(X + (size_t)m * DM, a.in[15], lane);
}

extern "C" void kernel_launch(void* const* d_in, const int* in_sizes, int n_in, void* d_out, int out_size, void* d_ws, size_t ws_size, hipStream_t stream) {
    static int grid = 0;
    if (grid == 0) {
        if (n_in != 16 || out_size != TT * DM || ws_size < WS_END) { fprintf(stderr, "kernel_launch: unexpected shapes (n_in %d, out %d, ws %zu)\n", n_in, out_size, ws_size); grid = -1; return; }
        int dev = 0, cus = 0, per_cu = 0;
        hipGetDevice(&dev); hipDeviceGetAttribute(&cus, hipDeviceAttributeMultiprocessorCount, dev);
        hipFuncSetAttribute((const void*)fwd_megakernel, hipFuncAttributeMaxDynamicSharedMemorySize, LDS_BYTES);
        hipOccupancyMaxActiveBlocksPerMultiprocessor(&per_cu, (const void*)fwd_megakernel, NWAVES * 64, LDS_BYTES);
        (void)hipGetLastError();
        if (per_cu < 1) per_cu = 1;
        grid = cus;
    }
    if (grid < 0) return;
    if (hipMemsetAsync((char*)d_ws + WS_CTL, 0, CTL_ZERO_BYTES, stream) != hipSuccess) { fprintf(stderr, "kernel_launch: memset failed\n"); return; }
    Args a{};
    for (int i = 0; i < 16; ++i) a.in[i] = (const float*)d_in[i];
    a.out = (float*)d_out; a.ws = (unsigned char*)d_ws;
    void* args[] = {&a};
    hipError_t e = hipLaunchCooperativeKernel((const void*)fwd_megakernel, dim3(grid), dim3(NWAVES * 64), args, LDS_BYTES, stream);
    if (e != hipSuccess) fprintf(stderr, "cooperative launch failed: %s (grid %d)\n", hipGetErrorString(e), grid);
}
```

```cpp
#include <hip/hip_runtime.h>
#include <hip/hip_cooperative_groups.h>
#include <cstdio>
#include <cstdint>
namespace cg = cooperative_groups;

#define LAS __attribute__((address_space(3)))
typedef unsigned short bf16_t;
typedef short bf16x8 __attribute__((ext_vector_type(8)));
typedef short s16x4 __attribute__((ext_vector_type(4)));
typedef float f32x4 __attribute__((ext_vector_type(4)));
typedef float f32x16 __attribute__((ext_vector_type(16)));
typedef unsigned u32x4 __attribute__((ext_vector_type(4)));
typedef unsigned u32x2 __attribute__((ext_vector_type(2)));

constexpr int SEQ = 4096, NB = 4, TT = NB * SEQ, DM = 1024, NMEM = 256, MROWS = NB * NMEM, FF = 2816, MAINW = 768, MEMW = 256, NHSB = 12, NHM = 4;
constexpr int PA = 2560;
constexpr int PB = 1024;
constexpr float EPS = 1e-6f, LOG2E = 1.4426950408889634f, LN2 = 0.6931471805599453f;

constexpr size_t MiB = 1u << 20;
constexpr size_t WS_CTL = 0, CTL_ZERO_BYTES = 65536;
constexpr size_t WS_SSQX = 1 * MiB;
constexpr size_t WS_SSQM = 2 * MiB;
constexpr size_t WS_MEMB = 3 * MiB;
constexpr size_t WS_MK = 5 * MiB;
constexpr size_t WS_MVT = 7 * MiB;
constexpr size_t WS_MKVW = 9 * MiB;
constexpr size_t WS_WSLOT = 13 * MiB, SLOT_BYTES = 24 * MiB;
constexpr size_t SL_WIN = 0, SL_WO = 5 * MiB, SL_WGU = 7 * MiB, SL_WD = 18 * MiB;
constexpr size_t WS_XB = 61 * MiB;
constexpr size_t WS_KSH = 93 * MiB;
constexpr size_t WS_VT = 117 * MiB;
constexpr size_t WS_PACT = 141 * MiB;
constexpr size_t WS_END = 229 * MiB;

constexpr int NWAVES = 8, LDS_BYTES = 147456;

namespace pg8 {
constexpr int BM = 256, BK = 64, HALF = 128, HTB = HALF * BK * 2, STAGE_BYTES = 8 * HTB, NXCD = 8, WGM = 8;
__host__ __device__ __forceinline__ int lds_byte(int r, int c) { const int st = (r >> 4) * 2 + (c >> 5), rr = r & 15, cc = c & 31, ob = rr * 64 + cc * 2; return st * 1024 + (ob ^ (((ob >> 9) & 1) << 5)); }
__host__ __device__ __forceinline__ void stage_rc(int b, int& R, int& C) { const int st = b / 1024, sb = b % 1024, swz = sb ^ (((sb >> 9) & 1) << 5); R = (st >> 1) * 16 + swz / 64; C = (st & 1) * 32 + (swz % 64) / 2; }
__host__ __device__ __forceinline__ int perm32(int rho) { const int n = rho >> 4, i = rho & 15; return 8 * (i >> 2) + 4 * n + (i & 3); }

struct Unit { int pm, pn; };
struct Gemm { const bf16_t* A; const bf16_t* Bt; int M, N, K, lda; };

struct StaticOrder {
    int nM, nN, nwg, G, c;
    __host__ __device__ void init(int M, int N, int G_, int c_) { nM = M / BM; nN = N / BM; nwg = nM * nN; G = G_; c = c_; }
    __host__ __device__ bool next(int i, Unit& u) const {
        const long L = (long)i * G + c; if (L >= nwg) return false;
        int wgid = (int)L; { const int q = nwg / NXCD, r = nwg % NXCD, xcd = wgid % NXCD, off = wgid / NXCD; wgid = (xcd < r ? xcd * (q + 1) : r * (q + 1) + (xcd - r) * q) + off; }
        const int nig = WGM * nN, gid = wgid / nig, fm = gid * WGM, gsz = (nM - fm) < WGM ? (nM - fm) : WGM;
        u.pm = fm + ((wgid % nig) % gsz); u.pn = (wgid % nig) / gsz; return true;
    }
};

typedef float f32x2_t __attribute__((ext_vector_type(2))); typedef __bf16 bf16x2_t __attribute__((ext_vector_type(2)));
__device__ __forceinline__ unsigned cvt_pk_bf16(float lo, float hi) { const f32x2_t v = {lo, hi}; const bf16x2_t b = __builtin_convertvector(v, bf16x2_t); return __builtin_bit_cast(unsigned, b); }

__device__ __forceinline__ float row_rs(const float* ssq, int row, int fq) {
    const f32x4 p = *(const f32x4*)(ssq + (size_t)row * 16 + 4 * fq);
    float s = (p[0] + p[1]) + (p[2] + p[3]);
    s += __shfl_xor(s, 16); s += __shfl_xor(s, 32);
    return __builtin_amdgcn_rsqf(s * (1.0f / 1024.0f) + EPS);
}
__device__ __forceinline__ void load_rs8(const float* ssq, int row0, int fq, float (&rs)[2][4]) {
    f32x4 p[2][4];
#pragma unroll
    for (int ai = 0; ai < 2; ++ai)
#pragma unroll
        for (int m = 0; m < 4; ++m) p[ai][m] = *(const f32x4*)(ssq + (size_t)(row0 + ai * HALF + m * 16) * 16 + 4 * fq);
    __builtin_amdgcn_sched_barrier(0);
#pragma unroll
    for (int ai = 0; ai < 2; ++ai)
#pragma unroll
        for (int m = 0; m < 4; ++m) { float s = (p[ai][m][0] + p[ai][m][1]) + (p[ai][m][2] + p[ai][m][3]); s += __shfl_xor(s, 16); s += __shfl_xor(s, 32); rs[ai][m] = __builtin_amdgcn_rsqf(s * (1.0f / 1024.0f) + EPS); }
    __builtin_amdgcn_sched_barrier(0);
}
__device__ __forceinline__ void store_tile_normal(const f32x4 (&acc)[2][2][4][2], const float (&rs)[2][4], bf16_t* base, int ld, int row0, int col0) {
#pragma unroll
    for (int ai = 0; ai < 2; ++ai)
#pragma unroll
        for (int m = 0; m < 4; ++m) { bf16_t* rowp = base + (size_t)(row0 + ai * HALF + m * 16) * ld + col0; const float s = rs[ai][m];
#pragma unroll
            for (int bj = 0; bj < 2; ++bj) { const f32x4 v0 = acc[ai][bj][m][0] * s, v1 = acc[ai][bj][m][1] * s;
                u32x4 w; w.x = cvt_pk_bf16(v0[0], v0[1]); w.y = cvt_pk_bf16(v0[2], v0[3]); w.z = cvt_pk_bf16(v1[0], v1[1]); w.w = cvt_pk_bf16(v1[2], v1[3]);
                *(u32x4*)(rowp + bj * HALF) = w; } }
}
__device__ __forceinline__ void store_tile_kfrag(const f32x4 (&acc)[2][2][4][2], const float (&rs)[2][4], bf16_t* OK, int sh, int nh, int ntile, int row0, int col0) {
#pragma unroll
    for (int ai = 0; ai < 2; ++ai)
#pragma unroll
        for (int m = 0; m < 4; ++m) { const int row = row0 + ai * HALF + m * 16; const float s = rs[ai][m];
            const int b = row >> sh, t = row & ((1 << sh) - 1), kt = t >> 5, r32 = t & 31;
#pragma unroll
            for (int bj = 0; bj < 2; ++bj) { const int c = col0 + bj * HALF, h = c >> 6, dch = (c & 63) >> 3;
                const f32x4 v0 = acc[ai][bj][m][0] * s, v1 = acc[ai][bj][m][1] * s;
                u32x4 w; w.x = cvt_pk_bf16(v0[0], v0[1]); w.y = cvt_pk_bf16(v0[2], v0[3]); w.z = cvt_pk_bf16(v1[0], v1[1]); w.w = cvt_pk_bf16(v1[2], v1[3]);
                *(u32x4*)(OK + ((((size_t)(b * nh + h) * ntile + kt) * 8 + dch) * 32 + r32) * 8) = w; } }
}
__device__ __forceinline__ void store_tile_vfrag(const f32x4 (&acc)[2][2][4][2], const float (&rs)[2][4], bf16_t* OV, int sh, int nh, int ntile, int row0, int col0) {
#pragma unroll
    for (int ai = 0; ai < 2; ++ai)
#pragma unroll
        for (int m = 0; m < 4; ++m) { const int row = row0 + ai * HALF + m * 16; const float s = rs[ai][m];
            const int b = row >> sh, t = row & ((1 << sh) - 1), kt = t >> 5, k = t & 31, ks = k >> 4, khi = (k >> 2) & 1, kj = (k & 3) | (((k >> 3) & 1) << 2);
#pragma unroll
            for (int bj = 0; bj < 2; ++bj) { const int c = col0 + bj * HALF, h = c >> 6, d = c & 63, dh = d >> 5, r0 = d & 31;
                bf16_t* tp = OV + (((size_t)(b * nh + h) * ntile + kt) * 2048) + ((((dh * 2 + ks) * 2 + khi) * 32 + r0) * 8 + kj);
#pragma unroll
                for (int n = 0; n < 2; ++n) { const f32x4 v = acc[ai][bj][m][n] * s; const unsigned w0 = cvt_pk_bf16(v[0], v[1]), w1 = cvt_pk_bf16(v[2], v[3]);
                    tp[(4 * n + 0) * 8] = (bf16_t)(w0 & 0xffffu); tp[(4 * n + 1) * 8] = (bf16_t)(w0 >> 16); tp[(4 * n + 2) * 8] = (bf16_t)(w1 & 0xffffu); tp[(4 * n + 3) * 8] = (bf16_t)(w1 >> 16); } } }
}
struct EpiProj {
    static constexpr bool PERM = true;
    __device__ __forceinline__ void init(f32x4 (&acc)[2][2][4][2], const Unit&, int, int, int, int) const {
#pragma unroll
        for (int a = 0; a < 2; ++a)
#pragma unroll
            for (int b = 0; b < 2; ++b)
#pragma unroll
                for (int m = 0; m < 4; ++m)
#pragma unroll
                    for (int n = 0; n < 2; ++n) acc[a][b][m][n] = (f32x4){0.f, 0.f, 0.f, 0.f};
    }
    const float* ssq; bf16_t* O0; int ld0, nt0; bf16_t* OKF; int nt1; bf16_t* OVF;
    __device__ __forceinline__ void operator()(const f32x4 (&acc)[2][2][4][2], const Unit& u, int wr, int wc, int fr, int fq) const {
        const int row0 = u.pm * BM + wr * 64 + fr; float rs[2][4]; load_rs8(ssq, row0, fq, rs);
        const int cw = wc * 32 + 8 * fq;
        if (u.pn < nt0) store_tile_normal(acc, rs, O0, ld0, row0, u.pn * BM + cw);
        else if (u.pn < nt0 + nt1) store_tile_kfrag(acc, rs, OKF, 12, NHSB, SEQ / 32, row0, (u.pn - nt0) * BM + cw);
        else store_tile_vfrag(acc, rs, OVF, 12, NHSB, SEQ / 32, row0, (u.pn - nt0 - nt1) * BM + cw);
    }
};
struct EpiMKV {
    static constexpr bool PERM = true;
    __device__ __forceinline__ void init(f32x4 (&acc)[2][2][4][2], const Unit&, int, int, int, int) const {
#pragma unroll
        for (int a = 0; a < 2; ++a)
#pragma unroll
            for (int b = 0; b < 2; ++b)
#pragma unroll
                for (int m = 0; m < 4; ++m)
#pragma unroll
                    for (int n = 0; n < 2; ++n) acc[a][b][m][n] = (f32x4){0.f, 0.f, 0.f, 0.f};
    }
    const float* ssq; bf16_t* MK; bf16_t* MVT;
    __device__ __forceinline__ void operator()(const f32x4 (&acc)[2][2][4][2], const Unit& u, int wr, int wc, int fr, int fq) const {
        const int row0 = u.pm * BM + wr * 64 + fr; float rs[2][4]; load_rs8(ssq, row0, fq, rs);
        const int cw = wc * 32 + 8 * fq, l = u.pn >> 1;
        if ((u.pn & 1) == 0) store_tile_kfrag(acc, rs, MK + (size_t)l * MROWS * 256, 8, NHM, NMEM / 32, row0, cw);
        else store_tile_vfrag(acc, rs, MVT + (size_t)l * MROWS * 256, 8, NHM, NMEM / 32, row0, cw);
    }
};
struct EpiSwiGLU {
    static constexpr bool PERM = true;
    __device__ __forceinline__ void init(f32x4 (&acc)[2][2][4][2], const Unit&, int, int, int, int) const {
#pragma unroll
        for (int a = 0; a < 2; ++a)
#pragma unroll
            for (int b = 0; b < 2; ++b)
#pragma unroll
                for (int m = 0; m < 4; ++m)
#pragma unroll
                    for (int n = 0; n < 2; ++n) acc[a][b][m][n] = (f32x4){0.f, 0.f, 0.f, 0.f};
    }
    const float* ssq; bf16_t* O; int ldc;
    __device__ __forceinline__ void operator()(const f32x4 (&acc)[2][2][4][2], const Unit& u, int wr, int wc, int fr, int fq) const {
        const int row0 = u.pm * BM + wr * 64 + fr, col0 = u.pn * HALF + wc * 32 + 8 * fq; float rs[2][4]; load_rs8(ssq, row0, fq, rs);
#pragma unroll
        for (int ai = 0; ai < 2; ++ai)
#pragma unroll
            for (int m = 0; m < 4; ++m) { const int row = row0 + ai * HALF + m * 16; const float s = rs[ai][m];
                float o[8];
#pragma unroll
                for (int n = 0; n < 2; ++n)
#pragma unroll
                    for (int i = 0; i < 4; ++i) { const float g = acc[ai][0][m][n][i] * s, up = acc[ai][1][m][n][i] * s;
                        o[4 * n + i] = g * __builtin_amdgcn_rcpf(1.0f + __builtin_amdgcn_exp2f(-g * LOG2E)) * up; }
                u32x4 w; w.x = cvt_pk_bf16(o[0], o[1]); w.y = cvt_pk_bf16(o[2], o[3]); w.z = cvt_pk_bf16(o[4], o[5]); w.w = cvt_pk_bf16(o[6], o[7]);
                *(u32x4*)(O + (size_t)row * ldc + col0) = w; }
    }
};
struct EpiRes {
    static constexpr bool PERM = true;
    const float* base; float* out; bf16_t* xb; float* ssq;
    __device__ __forceinline__ void init(f32x4 (&acc)[2][2][4][2], const Unit& u, int wr, int wc, int fr, int fq) const {
        const int row0 = u.pm * BM + wr * 64 + fr, col0 = u.pn * BM + wc * 32 + 8 * fq;
#pragma unroll
        for (int ai = 0; ai < 2; ++ai)
#pragma unroll
            for (int m = 0; m < 4; ++m) { const size_t off = (size_t)(row0 + ai * HALF + m * 16) * DM + col0;
#pragma unroll
                for (int bj = 0; bj < 2; ++bj) { acc[ai][bj][m][0] = *(const f32x4*)(base + off + bj * HALF); acc[ai][bj][m][1] = *(const f32x4*)(base + off + bj * HALF + 4); } }
    }
    __device__ __forceinline__ void operator()(const f32x4 (&acc)[2][2][4][2], const Unit& u, int wr, int wc, int fr, int fq) const {
        const int row0 = u.pm * BM + wr * 64 + fr, col0 = u.pn * BM + wc * 32 + 8 * fq;
#pragma unroll
        for (int ai = 0; ai < 2; ++ai)
#pragma unroll
            for (int m = 0; m < 4; ++m) { const int row = row0 + ai * HALF + m * 16; const size_t off = (size_t)row * DM + col0; float sq = 0.f;
#pragma unroll
                for (int bj = 0; bj < 2; ++bj) { const f32x4 x0 = acc[ai][bj][m][0], x1 = acc[ai][bj][m][1];
                    *(f32x4*)(out + off + bj * HALF) = x0; *(f32x4*)(out + off + bj * HALF + 4) = x1;
                    u32x4 w; w.x = cvt_pk_bf16(x0[0], x0[1]); w.y = cvt_pk_bf16(x0[2], x0[3]); w.z = cvt_pk_bf16(x1[0], x1[1]); w.w = cvt_pk_bf16(x1[2], x1[3]);
                    *(u32x4*)(xb + off + bj * HALF) = w;
                    sq += (x0[0] * x0[0] + x0[1] * x0[1]) + (x0[2] * x0[2] + x0[3] * x0[3]) + (x1[0] * x1[0] + x1[1] * x1[1]) + (x1[2] * x1[2] + x1[3] * x1[3]); }
                sq += __shfl_xor(sq, 16); sq += __shfl_xor(sq, 32);
                if (fq == 0) ssq[(size_t)row * 16 + u.pn * 4 + wc] = sq; }
    }
};

template <class Epi, class Sched, bool ALIGN_EPI>
__device__ __forceinline__ void gemm_phase(LAS unsigned char* lds, const Gemm g, const Sched& S, const Epi& E) {
    int tid = threadIdx.x; asm volatile("" : "+v"(tid));
    const int wid = __builtin_amdgcn_readfirstlane(tid >> 6), lane = tid & 63, wr = wid >> 2, wc = wid & 3, fr = lane & 15, fq = lane >> 4;
    const int K = g.K, nt = K / BK;
    unsigned voffA[2], voffB[2];
#pragma unroll
    for (int i = 0; i < 2; ++i) { int R, C; stage_rc(tid * 16 + i * 8192, R, C); const int Rb = Epi::PERM ? ((R & ~31) + perm32(R & 31)) : R;
        voffA[i] = (unsigned)(R * g.lda + C) * 2u; voffB[i] = (unsigned)(Rb * K + C) * 2u; }
    const size_t kstep = (size_t)(BK * 2);
    const size_t hstepA = (size_t)HALF * g.lda * 2, hstepB = (size_t)HALF * K * 2;
    const size_t tstepA = 2 * hstepA, tstepB = 2 * hstepB;
    const unsigned ldsw = (unsigned)wid * 1024u;
    const int aoff = lds_byte(wr * 64 + fr, fq * 8), boff = lds_byte(wc * 32 + fr, fq * 8);
#define PG8_SA(b, h) (((b) * 2 + (h)) * HTB)
#define PG8_SB(b, h) ((4 + (b) * 2 + (h)) * HTB)
#define PG8_STAGE(bufoff, gbase, voff) do { _Pragma("unroll") for (int _i = 0; _i < 2; ++_i) \
        __builtin_amdgcn_global_load_lds((const unsigned*)((const char*)(gbase) + (voff)[_i]), (LAS unsigned*)(lds + (bufoff) + ldsw + _i * 8192), 16, 0, 0); } while (0)
#define PG8_LDA(dst, b, h) do { _Pragma("unroll") for (int m = 0; m < 4; ++m) _Pragma("unroll") for (int k = 0; k < 2; ++k) dst[m][k] = *(const LAS bf16x8*)(lds + PG8_SA(b, h) + aoff + m * 2048 + k * 1024); } while (0)
#define PG8_LDB(dst, b, h) do { _Pragma("unroll") for (int n = 0; n < 2; ++n) _Pragma("unroll") for (int k = 0; k < 2; ++k) dst[n][k] = *(const LAS bf16x8*)(lds + PG8_SB(b, h) + boff + n * 2048 + k * 1024); } while (0)
#define PG8_MMA(ai, bj, At, Bt) do { __builtin_amdgcn_s_setprio(1); _Pragma("unroll") for (int m = 0; m < 4; ++m) _Pragma("unroll") for (int n = 0; n < 2; ++n) _Pragma("unroll") for (int k = 0; k < 2; ++k) \
        acc[ai][bj][m][n] = __builtin_amdgcn_mfma_f32_16x16x32_bf16(Bt[n][k], At[m][k], acc[ai][bj][m][n], 0, 0, 0); __builtin_amdgcn_s_setprio(0); } while (0)
#define PG8_WAIT_V(n) asm volatile("s_waitcnt vmcnt(" #n ")" ::: "memory")
#define PG8_WAIT_L(n) asm volatile("s_waitcnt lgkmcnt(" #n ")" ::: "memory")
#define PG8_BAR __builtin_amdgcn_s_barrier()
#define PG8_SCHED __builtin_amdgcn_sched_barrier(0)
    Unit cur, nxt; int ui = 0;
    if (!S.next(0, cur)) return;
    f32x4 acc[2][2][4][2];
    E.init(acc, cur, wr, wc, fr, fq);
    bf16x8 At[4][2], B0[2][2], B1[2][2];
    const char* cA = (const char*)g.A + (size_t)cur.pm * tstepA; const char* cB = (const char*)g.Bt + (size_t)cur.pn * tstepB;
    PG8_STAGE(PG8_SB(0, 0), cB, voffB); PG8_STAGE(PG8_SB(0, 1), cB + hstepB, voffB); PG8_STAGE(PG8_SA(0, 0), cA, voffA); PG8_STAGE(PG8_SA(0, 1), cA + hstepA, voffA);
    if (wr == 1) PG8_BAR;
    PG8_WAIT_V(2); PG8_BAR;
    PG8_STAGE(PG8_SB(1, 0), cB + kstep, voffB); PG8_STAGE(PG8_SA(1, 0), cA + kstep, voffA); PG8_STAGE(PG8_SB(1, 1), cB + hstepB + kstep, voffB);
    PG8_WAIT_V(6); PG8_BAR;
    for (;;) {
        const bool has_next = S.next(ui + 1, nxt);
        const char* nA = has_next ? (const char*)g.A + (size_t)nxt.pm * tstepA : cA; const char* nB = has_next ? (const char*)g.Bt + (size_t)nxt.pn * tstepB : cB;
        for (int t = 0; t < nt; t += 2) {
            const bool last = (t == nt - 2);
            const char* a1 = cA + (size_t)(t + 1) * kstep;
            const char* a2 = last ? nA : cA + (size_t)(t + 2) * kstep; const char* b2 = last ? nB : cB + (size_t)(t + 2) * kstep;
            const char* a3 = a2 + kstep; const char* b3 = b2 + kstep;
            PG8_LDB(B0, 0, 0); PG8_LDB(B1, 0, 1); PG8_SCHED; PG8_LDA(At, 0, 0); PG8_STAGE(PG8_SA(1, 1), a1 + hstepA, voffA);
            PG8_WAIT_V(8); PG8_WAIT_L(0); PG8_BAR; PG8_MMA(0, 0, At, B0); PG8_MMA(0, 1, At, B1); PG8_BAR; PG8_SCHED;
            PG8_LDA(At, 0, 1); PG8_STAGE(PG8_SB(0, 0), b2, voffB); PG8_STAGE(PG8_SB(0, 1), b2 + hstepB, voffB); PG8_STAGE(PG8_SA(0, 0), a2, voffA);
            PG8_WAIT_V(8); PG8_WAIT_L(0); PG8_BAR; PG8_MMA(1, 0, At, B0); PG8_MMA(1, 1, At, B1); PG8_BAR; PG8_SCHED;
            PG8_LDB(B0, 1, 0); PG8_LDB(B1, 1, 1); PG8_SCHED; PG8_LDA(At, 1, 0); PG8_STAGE(PG8_SA(0, 1), a2 + hstepA, voffA);
            PG8_WAIT_V(8); PG8_WAIT_L(0); PG8_BAR; PG8_MMA(0, 0, At, B0); PG8_MMA(0, 1, At, B1); PG8_BAR; PG8_SCHED;
            PG8_LDA(At, 1, 1); PG8_STAGE(PG8_SB(1, 0), b3, voffB); PG8_STAGE(PG8_SB(1, 1), b3 + hstepB, voffB); PG8_STAGE(PG8_SA(1, 0), a3, voffA);
            PG8_WAIT_V(8); PG8_WAIT_L(0); PG8_BAR; PG8_MMA(1, 0, At, B0); PG8_MMA(1, 1, At, B1); PG8_BAR; PG8_SCHED;
        }
        if constexpr (ALIGN_EPI) { if (wr == 0) PG8_BAR; }
        E(acc, cur, wr, wc, fr, fq);
        if (!has_next) break;
        E.init(acc, nxt, wr, wc, fr, fq);
        cur = nxt; cA = nA; cB = nB; ++ui;
        if constexpr (ALIGN_EPI) { if (wr == 1) PG8_BAR; }
    }
    PG8_WAIT_V(0);
    if constexpr (!ALIGN_EPI) { if (wr == 0) PG8_BAR; }
    PG8_BAR;
#undef PG8_SA
#undef PG8_SB
#undef PG8_STAGE
#undef PG8_LDA
#undef PG8_LDB
#undef PG8_MMA
#undef PG8_WAIT_V
#undef PG8_WAIT_L
#undef PG8_BAR
#undef PG8_SCHED
}
}

__device__ __forceinline__ float wave_sum(float v) {
#pragma unroll
    for (int o = 1; o < 64; o <<= 1) v += __shfl_xor(v, o);
    return v;
}
__device__ __forceinline__ unsigned pk2(float lo, float hi) { return pg8::cvt_pk_bf16(lo, hi); }
__device__ __forceinline__ float bf_lo(unsigned w) { return __uint_as_float(w << 16); }
__device__ __forceinline__ float bf_hi(unsigned w) { return __uint_as_float(w & 0xffff0000u); }
__device__ __forceinline__ int crow(int r, int hi) { return (r & 3) + 8 * (r >> 2) + 4 * hi; }

__device__ __forceinline__ void tr_item(const float* W, int N, int k0, int n0, const float* gain, float scale, bf16_t* WT, int Kd, int drow0, LAS float* scr, int lane) {
    float wv[32]; const float gl = gain ? gain[k0 + lane] * scale : scale;
#pragma unroll
    for (int i = 0; i < 32; ++i) wv[i] = W[(size_t)(k0 + 2 * i + (lane >> 5)) * N + n0 + (lane & 31)];
    __builtin_amdgcn_sched_barrier(0);
#pragma unroll
    for (int i = 0; i < 32; ++i) { const float g0 = __shfl(gl, 2 * i), g1 = __shfl(gl, 2 * i + 1); scr[(2 * i + (lane >> 5)) * 33 + (lane & 31)] = wv[i] * ((lane >> 5) ? g1 : g0); }
    asm volatile("s_waitcnt lgkmcnt(0)" ::: "memory");
    const int c = lane & 7;
#pragma unroll
    for (int j = 0; j < 4; ++j) { const int n = (lane >> 3) + 8 * j; const LAS float* s = scr + (8 * c) * 33 + n;
        u32x4 o; o.x = pk2(s[0 * 33], s[1 * 33]); o.y = pk2(s[2 * 33], s[3 * 33]); o.z = pk2(s[4 * 33], s[5 * 33]); o.w = pk2(s[6 * 33], s[7 * 33]);
        *(u32x4*)(WT + (size_t)(drow0 + n) * Kd + k0 + 8 * c) = o; }
    asm volatile("s_waitcnt lgkmcnt(0)" ::: "memory");
}
enum { MAP_ID = 0, MAP_AIN = 1, MAP_GATE = 2, MAP_UP = 3 };
__device__ __forceinline__ void conv_job(int& base, const float* W, int K, int N, const float* gain, float scale, bf16_t* WT, int Kd, int map, int row_off, LAS float* scr, int gw, int ngw, int lane) {
    const int nblk = N / 32, nitems = (K / 64) * nblk;
    int first = (gw - (base % ngw)); if (first < 0) first += ngw;
    for (int it = first; it < nitems; it += ngw) {
        const int kb = it / nblk, nb = it % nblk, n0 = 32 * nb; int drow0 = row_off + n0; float sc = scale;
        if (map == MAP_AIN) { if (n0 < 768) drow0 = n0; else if (n0 < 1536) drow0 = n0 - 768 + 1024; else if (n0 < 2304) drow0 = n0 - 1536 + 1792; else { drow0 = n0 - 2304 + 768; sc = 0.125f; } }
        else if (map == MAP_GATE) drow0 = (n0 >> 7) * 256 + (n0 & 127);
        else if (map == MAP_UP) drow0 = (n0 >> 7) * 256 + 128 + (n0 & 127);
        tr_item(W, N, 64 * kb, n0, gain, sc, WT, Kd, drow0, scr, lane);
    }
    base += nitems;
}

struct Args { const float* in[16]; float* out; unsigned char* ws; };

__device__ __forceinline__ void convert_layer(const Args& a, int l, int& base, LAS float* scr, int gw, int ngw, int lane) {
    unsigned char* slot = a.ws + WS_WSLOT + (size_t)(l & 1) * SLOT_BYTES;
    bf16_t* WIN = (bf16_t*)(slot + SL_WIN); bf16_t* WO = (bf16_t*)(slot + SL_WO); bf16_t* WGU = (bf16_t*)(slot + SL_WGU); bf16_t* WD = (bf16_t*)(slot + SL_WD);
    const float* mixg = a.in[2] + (size_t)l * DM; const float* ffng = a.in[10] + (size_t)l * DM;
    if (l < 2) conv_job(base, a.in[3] + (size_t)l * DM * PA, DM, PA, mixg, 1.0f, WIN, DM, MAP_AIN, 0, scr, gw, ngw, lane);
    else {
        conv_job(base, a.in[5] + (size_t)(l - 2) * DM * DM, DM, DM, mixg, 0.125f, WIN, DM, MAP_ID, 0, scr, gw, ngw, lane);
        if (l == 2) conv_job(base, a.in[7], DM, 2 * MAINW, a.in[6], 1.0f, WIN, DM, MAP_ID, DM, scr, gw, ngw, lane);
    }
    conv_job(base, a.in[9] + (size_t)l * DM * DM, DM, DM, nullptr, 1.0f, WO, DM, MAP_ID, 0, scr, gw, ngw, lane);
    conv_job(base, a.in[11] + (size_t)l * DM * FF, DM, FF, ffng, 1.0f, WGU, DM, MAP_GATE, 0, scr, gw, ngw, lane);
    conv_job(base, a.in[12] + (size_t)l * DM * FF, DM, FF, ffng, 1.0f, WGU, DM, MAP_UP, 0, scr, gw, ngw, lane);
    conv_job(base, a.in[13] + (size_t)l * FF * DM, FF, DM, nullptr, 1.0f, WD, FF, MAP_ID, 0, scr, gw, ngw, lane);
}

__device__ __forceinline__ void row_to_bf16_ssq(const float* xrow, bf16_t* orow, float* ssq16, int lane) {
    const f32x4* xr = (const f32x4*)xrow + lane; f32x4 v[4]; float s = 0.f;
#pragma unroll
    for (int j = 0; j < 4; ++j) v[j] = xr[64 * j];
    __builtin_amdgcn_sched_barrier(0);
#pragma unroll
    for (int j = 0; j < 4; ++j) s += (v[j][0] * v[j][0] + v[j][1] * v[j][1]) + (v[j][2] * v[j][2] + v[j][3] * v[j][3]);
    s = wave_sum(s);
    u32x2* o8 = (u32x2*)orow + lane;
#pragma unroll
    for (int j = 0; j < 4; ++j) { u32x2 w; w.x = pk2(v[j][0], v[j][1]); w.y = pk2(v[j][2], v[j][3]); o8[64 * j] = w; }
    if (lane < 4) *(f32x4*)(ssq16 + 4 * lane) = (f32x4){lane == 0 ? s : 0.f, 0.f, 0.f, 0.f};
}
__device__ __forceinline__ void final_row(float* xrow, const float* g, int lane) {
    f32x4* xr = (f32x4*)xrow + lane; const f32x4* gr = (const f32x4*)g + lane; f32x4 v[4]; float s = 0.f;
#pragma unroll
    for (int j = 0; j < 4; ++j) v[j] = xr[64 * j];
    f32x4 gv[4];
#pragma unroll
    for (int j = 0; j < 4; ++j) gv[j] = gr[64 * j];
    __builtin_amdgcn_sched_barrier(0);
#pragma unroll
    for (int j = 0; j < 4; ++j) s += (v[j][0] * v[j][0] + v[j][1] * v[j][1]) + (v[j][2] * v[j][2] + v[j][3] * v[j][3]);
    s = wave_sum(s); const float rs = 1.0f / sqrtf(s * (1.0f / 1024.0f) + EPS);
#pragma unroll
    for (int j = 0; j < 4; ++j) xr[64 * j] = v[j] * rs * gv[j];
}

__device__ __forceinline__ void conv_items(bf16_t* P, const float* cw, int gtid, int nthreads) {
    for (int it = gtid; it < (TT / 16) * 96; it += nthreads) {
        const int cgp = it % 96, ch = it / 96, row0 = ch * 16, c0 = cgp * 8, t0 = row0 & (SEQ - 1);
        float w0[8], w1[8], w2[8], p2[8], p1[8];
#pragma unroll
        for (int i = 0; i < 8; ++i) { w0[i] = cw[c0 + i]; w1[i] = cw[MAINW + c0 + i]; w2[i] = cw[2 * MAINW + c0 + i]; p2[i] = 0.f; p1[i] = 0.f; }
        if (t0 >= 2) {
            const bf16_t* r2 = P + (size_t)(row0 - 2) * PA; const bf16_t* r1 = P + (size_t)(row0 - 1) * PA;
            const u32x4 g2 = *(const u32x4*)(r2 + 1024 + c0), u2 = *(const u32x4*)(r2 + 1792 + c0), g1 = *(const u32x4*)(r1 + 1024 + c0), u1 = *(const u32x4*)(r1 + 1792 + c0);
#pragma unroll
            for (int i = 0; i < 4; ++i) { p2[2 * i] = bf_lo(g2[i]) * bf_lo(u2[i]); p2[2 * i + 1] = bf_hi(g2[i]) * bf_hi(u2[i]); p1[2 * i] = bf_lo(g1[i]) * bf_lo(u1[i]); p1[2 * i + 1] = bf_hi(g1[i]) * bf_hi(u1[i]); }
        }
#pragma unroll 1
        for (int i0 = 0; i0 < 16; i0 += 4) {
            u32x4 gg[4], uu[4], bb[4];
#pragma unroll
            for (int j = 0; j < 4; ++j) { const bf16_t* r = P + (size_t)(row0 + i0 + j) * PA; gg[j] = *(const u32x4*)(r + 1024 + c0); uu[j] = *(const u32x4*)(r + 1792 + c0); bb[j] = *(const u32x4*)(r + c0); }
            __builtin_amdgcn_sched_barrier(0);
#pragma unroll
            for (int j = 0; j < 4; ++j) {
                float cu[8], y[8];
#pragma unroll
                for (int q = 0; q < 4; ++q) { cu[2 * q] = bf_lo(gg[j][q]) * bf_lo(uu[j][q]); cu[2 * q + 1] = bf_hi(gg[j][q]) * bf_hi(uu[j][q]); }
#pragma unroll
                for (int q = 0; q < 4; ++q) { y[2 * q] = bf_lo(bb[j][q]) * (w0[2 * q] * p2[2 * q] + w1[2 * q] * p1[2 * q] + w2[2 * q] * cu[2 * q]);
                    y[2 * q + 1] = bf_hi(bb[j][q]) * (w0[2 * q + 1] * p2[2 * q + 1] + w1[2 * q + 1] * p1[2 * q + 1] + w2[2 * q + 1] * cu[2 * q + 1]); }
                u32x4 o; o.x = pk2(y[0], y[1]); o.y = pk2(y[2], y[3]); o.z = pk2(y[4], y[5]); o.w = pk2(y[6], y[7]);
                *(u32x4*)(P + (size_t)(row0 + i0 + j) * PA + c0) = o;
#pragma unroll
                for (int q = 0; q < 8; ++q) { p2[q] = p1[q]; p1[q] = cu[q]; }
            }
        }
    }
}

__device__ __forceinline__ float half_max(float m) { auto rr = __builtin_amdgcn_permlane32_swap(__float_as_uint(m), __float_as_uint(m), false, false); return fmaxf(__uint_as_float(rr[0]), __uint_as_float(rr[1])); }
__device__ __forceinline__ bf16x8 pack8(const f32x16& p, int s) {
    u32x4 w; w.x = pk2(p[8 * s + 0], p[8 * s + 1]); w.y = pk2(p[8 * s + 2], p[8 * s + 3]); w.z = pk2(p[8 * s + 4], p[8 * s + 5]); w.w = pk2(p[8 * s + 6], p[8 * s + 7]);
    return __builtin_bit_cast(bf16x8, w);
}
__device__ __forceinline__ bf16x8 vfrag(const bf16_t* p) {
    const s16x4 lo = *(const s16x4*)p, hi = *(const s16x4*)(p + 8);
    return (bf16x8){lo[0], lo[1], lo[2], lo[3], hi[0], hi[1], hi[2], hi[3]};
}
__device__ __forceinline__ void store_o(bf16_t* qp, const f32x16& o0, const f32x16& o1, float sc, int hi) {
#pragma unroll
    for (int g = 0; g < 4; ++g) { u32x2 w; w.x = pk2(o0[4 * g] * sc, o0[4 * g + 1] * sc); w.y = pk2(o0[4 * g + 2] * sc, o0[4 * g + 3] * sc); *(u32x2*)(qp + 8 * g + 4 * hi) = w; }
#pragma unroll
    for (int g = 0; g < 4; ++g) { u32x2 w; w.x = pk2(o1[4 * g] * sc, o1[4 * g + 1] * sc); w.y = pk2(o1[4 * g + 2] * sc, o1[4 * g + 3] * sc); *(u32x2*)(qp + 32 + 8 * g + 4 * hi) = w; }
}

__device__ __forceinline__ void mem_attn_item(bf16_t* P, int pitch, const bf16_t* MK, const bf16_t* MVT, int item, int lane) {
    const int qb = item & 127, hm = (item >> 7) & 3, b = item >> 9, r32 = lane & 31, hi = lane >> 5;
    bf16_t* qp = P + (size_t)(b * SEQ + qb * 32 + r32) * pitch + MAINW + hm * 64;
    const bf16_t* kp = MK + (size_t)(b * NHM + hm) * (NMEM / 32) * 2048 + (hi * 32 + r32) * 8;
    const bf16_t* vp = MVT + (size_t)(b * NHM + hm) * (NMEM / 32) * 2048 + (hi * 32 + r32) * 8;
    bf16x8 qf[4], kc[4], kn[4];
#pragma unroll
    for (int d0 = 0; d0 < 4; ++d0) qf[d0] = *(const bf16x8*)(qp + d0 * 16 + hi * 8);
#pragma unroll
    for (int d0 = 0; d0 < 4; ++d0) kc[d0] = *(const bf16x8*)(kp + d0 * 512);
    f32x16 sc[8];
#pragma unroll
    for (int mt = 0; mt < 8; ++mt) {
        if (mt < 7) {
#pragma unroll
            for (int d0 = 0; d0 < 4; ++d0) kn[d0] = *(const bf16x8*)(kp + (mt + 1) * 2048 + d0 * 512); }
        __builtin_amdgcn_sched_barrier(0);
        f32x16 z = {};
#pragma unroll
        for (int d0 = 0; d0 < 4; ++d0) z = __builtin_amdgcn_mfma_f32_32x32x16_bf16(kc[d0], qf[d0], z, 0, 0, 0);
        sc[mt] = z;
        __builtin_amdgcn_sched_barrier(0);
#pragma unroll
        for (int d0 = 0; d0 < 4; ++d0) kc[d0] = kn[d0];
    }
    bf16x8 vc[4], vn[4];
#pragma unroll
    for (int i = 0; i < 4; ++i) vc[i] = *(const bf16x8*)(vp + (2 * (i & 1) + (i >> 1)) * 512);
    __builtin_amdgcn_sched_barrier(0);
    float mx = -INFINITY;
#pragma unroll
    for (int mt = 0; mt < 8; ++mt)
#pragma unroll
        for (int r = 0; r < 16; ++r) mx = fmaxf(mx, sc[mt][r]);
    mx = half_max(mx);
    float l = 0.f;
#pragma unroll
    for (int mt = 0; mt < 8; ++mt)
#pragma unroll
        for (int r = 0; r < 16; ++r) { const float e = __builtin_amdgcn_exp2f((sc[mt][r] - mx) * LOG2E); sc[mt][r] = e; l += e; }
    { auto rr = __builtin_amdgcn_permlane32_swap(__float_as_uint(l), __float_as_uint(l), false, false); l = __uint_as_float(rr[0]) + __uint_as_float(rr[1]); }
    f32x16 o0 = {}, o1 = {};
#pragma unroll
    for (int mt = 0; mt < 8; ++mt) {
        if (mt < 7) {
#pragma unroll
            for (int i = 0; i < 4; ++i) vn[i] = *(const bf16x8*)(vp + (mt + 1) * 2048 + (2 * (i & 1) + (i >> 1)) * 512); }
        __builtin_amdgcn_sched_barrier(0);
        const bf16x8 p0 = pack8(sc[mt], 0), p1 = pack8(sc[mt], 1);
        o0 = __builtin_amdgcn_mfma_f32_32x32x16_bf16(vc[0], p0, o0, 0, 0, 0); o1 = __builtin_amdgcn_mfma_f32_32x32x16_bf16(vc[1], p0, o1, 0, 0, 0);
        o0 = __builtin_amdgcn_mfma_f32_32x32x16_bf16(vc[2], p1, o0, 0, 0, 0); o1 = __builtin_amdgcn_mfma_f32_32x32x16_bf16(vc[3], p1, o1, 0, 0, 0);
        __builtin_amdgcn_sched_barrier(0);
#pragma unroll
        for (int i = 0; i < 4; ++i) vc[i] = vn[i];
    }
    store_o(qp, o0, o1, 1.0f / l, hi);
}

__device__ __forceinline__ void sb_attn_item(bf16_t* P, const bf16_t* Ksh, const bf16_t* VT, int item, int lane) {
    const int qb = item & 127, bh = item >> 7, h = bh % NHSB, b = bh / NHSB, r32 = lane & 31, hi = lane >> 5;
    bf16_t* qp = P + (size_t)(b * SEQ + qb * 32 + r32) * PB + h * 64;
    const bf16_t* kbase = Ksh + (size_t)(b * NHSB + h) * (SEQ / 32) * 2048 + (hi * 32 + r32) * 8;
    const bf16_t* vbase = VT + (size_t)(b * NHSB + h) * (SEQ / 32) * 2048 + (hi * 32 + r32) * 8;
    bf16x8 qf[4], kc[4], vc[4], kn[4], vn[4];
#pragma unroll
    for (int d0 = 0; d0 < 4; ++d0) qf[d0] = *(const bf16x8*)(qp + d0 * 16 + hi * 8);
#pragma unroll
    for (int d0 = 0; d0 < 4; ++d0) kc[d0] = *(const bf16x8*)(kbase + qb * 2048 + d0 * 512);
#pragma unroll
    for (int i = 0; i < 4; ++i) vc[i] = *(const bf16x8*)(vbase + qb * 2048 + (2 * (i & 1) + (i >> 1)) * 512);
    float C = 0.f; f32x16 o0 = {}, o1 = {};
    for (int kt = qb; kt >= 0; --kt) {
        const int ktn = kt > 0 ? kt - 1 : 0;
#pragma unroll
        for (int d0 = 0; d0 < 4; ++d0) kn[d0] = *(const bf16x8*)(kbase + ktn * 2048 + d0 * 512);
#pragma unroll
        for (int i = 0; i < 4; ++i) vn[i] = *(const bf16x8*)(vbase + ktn * 2048 + (2 * (i & 1) + (i >> 1)) * 512);
        __builtin_amdgcn_sched_barrier(0);
        f32x16 z = {};
#pragma unroll
        for (int d0 = 0; d0 < 4; ++d0) z = __builtin_amdgcn_mfma_f32_32x32x16_bf16(kc[d0], qf[d0], z, 0, 0, 0);
        const bool diag = (kt == qb);
        float ln[16], zl[16];
#pragma unroll
        for (int r = 0; r < 16; ++r) { const float zz = z[r], e = __builtin_amdgcn_exp2f(-fabsf(zz) * LOG2E), sp = fmaxf(zz, 0.f) + LN2 * __builtin_amdgcn_logf(1.0f + e);
            const bool valid = !diag || (crow(r, hi) < r32);
            ln[r] = valid ? -sp : 0.f; zl[r] = valid ? (zz - sp) : -INFINITY; }
        float G0[4], G1[4];
#pragma unroll
        for (int g = 0; g < 4; ++g) { const float gs = (ln[4 * g] + ln[4 * g + 1]) + (ln[4 * g + 2] + ln[4 * g + 3]);
            const float ot = __shfl_xor(gs, 32); G0[g] = hi ? ot : gs; G1[g] = hi ? gs : ot; }
        float R = C;
        f32x16 a;
#pragma unroll
        for (int g = 3; g >= 0; --g) {
            float tl = R + (hi == 0 ? G1[g] : 0.f);
            a[4 * g + 3] = __builtin_amdgcn_exp2f((zl[4 * g + 3] + tl) * LOG2E); tl += ln[4 * g + 3];
            a[4 * g + 2] = __builtin_amdgcn_exp2f((zl[4 * g + 2] + tl) * LOG2E); tl += ln[4 * g + 2];
            a[4 * g + 1] = __builtin_amdgcn_exp2f((zl[4 * g + 1] + tl) * LOG2E); tl += ln[4 * g + 1];
            a[4 * g + 0] = __builtin_amdgcn_exp2f((zl[4 * g + 0] + tl) * LOG2E);
            R += G0[g] + G1[g];
        }
        C = R;
        const bf16x8 p0 = pack8(a, 0), p1 = pack8(a, 1);
        o0 = __builtin_amdgcn_mfma_f32_32x32x16_bf16(vc[0], p0, o0, 0, 0, 0); o1 = __builtin_amdgcn_mfma_f32_32x32x16_bf16(vc[1], p0, o1, 0, 0, 0);
        o0 = __builtin_amdgcn_mfma_f32_32x32x16_bf16(vc[2], p1, o0, 0, 0, 0); o1 = __builtin_amdgcn_mfma_f32_32x32x16_bf16(vc[3], p1, o1, 0, 0, 0);
        __builtin_amdgcn_sched_barrier(0);
#pragma unroll
        for (int i = 0; i < 4; ++i) { kc[i] = kn[i]; vc[i] = vn[i]; }
        if (__all(C < -110.0f)) break;
    }
    store_o(qp, o0, o1, 1.0f, hi);
}

#define XB_TMO      128
#define XB_XCNT(j)  (256  + 64 * (j))
#define XB_XSUB(j)  (1280 + 64 * (j))
#define XB_XGEN(j)  (2304 + 64 * (j))
#define XB_TOP      3328
#define XB_TOPGEN   3392
#define XCD_BAR_WORDS 3456
#define XB_SPIN_CAP (1u << 18)
__device__ __forceinline__ unsigned xb_ld(unsigned* p)              { return __hip_atomic_load(p, __ATOMIC_RELAXED, __HIP_MEMORY_SCOPE_AGENT); }
__device__ __forceinline__ unsigned xb_add(unsigned* p, unsigned v) { return __hip_atomic_fetch_add(p, v, __ATOMIC_RELAXED, __HIP_MEMORY_SCOPE_AGENT); }
__device__ __forceinline__ unsigned xb_xcc_id() { return (unsigned)__builtin_amdgcn_s_getreg((3 << 11) | 20) & 0xFu; }
#define XB_SPIN(cond, bar) do { unsigned _sp = 0; while (cond) { __builtin_amdgcn_s_sleep(1); \
    if ((++_sp & 255u) == 0u) { if (xb_ld(&(bar)[XB_TMO])) break; if (_sp > XB_SPIN_CAP) { atomicAdd(&(bar)[XB_TMO], 1u); break; } } } } while (0)
struct XcdBarrier { unsigned* bar; unsigned x; volatile LAS unsigned* st; };
__device__ __forceinline__ XcdBarrier xcd_barrier_post(unsigned* bar, volatile LAS unsigned* st) {
    XcdBarrier b; b.bar = bar; b.x = xb_xcc_id(); b.st = st;
    if (threadIdx.x == 0) (void)xb_add(&bar[XB_XCNT(b.x)], 1u);
    return b;
}
__device__ __forceinline__ void xcd_barrier_complete(unsigned* bar, unsigned x, unsigned& nloc, unsigned& nx) {
    const unsigned G = gridDim.x * gridDim.y * gridDim.z;
    unsigned sum, cnt, mine, sp = 0u;
    for (;;) {
        sum = 0u; cnt = 0u; mine = 0u;
#pragma unroll
        for (unsigned j = 0; j < 16; ++j) { const unsigned c = xb_ld(&bar[XB_XCNT(j)]); sum += c; cnt += (c > 0u) ? 1u : 0u; mine = (j == x) ? c : mine; }
        if (sum == G) break;
        __builtin_amdgcn_s_sleep(1);
        if ((++sp & 255u) == 0u) { if (xb_ld(&bar[XB_TMO])) break; if (sp > XB_SPIN_CAP) { atomicAdd(&bar[XB_TMO], 1u); break; } }
    }
    nloc = mine > 0u ? mine : 1u; nx = cnt > 0u ? cnt : 1u;
}
__device__ __forceinline__ void xcd_barrier(const XcdBarrier& b) {
    asm volatile("s_waitcnt vmcnt(0)" ::: "memory");
    __syncthreads();
    if (threadIdx.x == 0) {
        unsigned* bar = b.bar;
        __builtin_amdgcn_s_waitcnt(0);
        unsigned nloc = b.st[0], nx = b.st[1];
        if (nloc == 0u) { xcd_barrier_complete(bar, b.x, nloc, nx); b.st[0] = nloc; b.st[1] = nx; }
        const unsigned old = xb_add(&bar[XB_XSUB(b.x)], 1u);
        const unsigned gen = old / nloc;
        if (old + 1u == (gen + 1u) * nloc) {
            __builtin_amdgcn_fence(__ATOMIC_RELEASE, "agent");
            asm volatile("s_waitcnt vmcnt(0)" ::: "memory");
            const unsigned og = xb_add(&bar[XB_TOP], 1u);
            const unsigned tg = og / nx;
            if (og + 1u == (tg + 1u) * nx) xb_add(&bar[XB_TOPGEN], 1u);
            else XB_SPIN(xb_ld(&bar[XB_TOPGEN]) == tg, bar);
            __builtin_amdgcn_fence(__ATOMIC_ACQUIRE, "agent");
            xb_add(&bar[XB_XGEN(b.x)], 1u);
            asm volatile("s_waitcnt vmcnt(0)" ::: "memory");
        } else {
            XB_SPIN(xb_ld(&bar[XB_XGEN(b.x)]) == gen, bar);
            __builtin_amdgcn_fence(__ATOMIC_ACQUIRE, "agent");
            asm volatile("s_waitcnt vmcnt(0)" ::: "memory");
        }
    }
    __syncthreads();
}

__global__ void __launch_bounds__(NWAVES * 64, 2) fwd_megakernel(Args a) {
    extern __shared__ __attribute__((aligned(16))) unsigned char lds_raw[];
    cg::grid_group grid = cg::this_grid();
    LAS unsigned char* lds = (LAS unsigned char*)lds_raw;
    const int tid = threadIdx.x, lane = tid & 63, wave = __builtin_amdgcn_readfirstlane(tid >> 6);
    const int G = gridDim.x, bx = blockIdx.x;
    const int gw = bx * NWAVES + wave, ngw = G * NWAVES, gtid = bx * (NWAVES * 64) + tid, nthreads = G * NWAVES * 64;
    unsigned char* ws = a.ws;
    float* X = a.out;
    float* SSQX = (float*)(ws + WS_SSQX); float* SSQM = (float*)(ws + WS_SSQM);
    bf16_t* MEMB = (bf16_t*)(ws + WS_MEMB); bf16_t* MK = (bf16_t*)(ws + WS_MK); bf16_t* MVT = (bf16_t*)(ws + WS_MVT); bf16_t* MKVW = (bf16_t*)(ws + WS_MKVW);
    bf16_t* XB = (bf16_t*)(ws + WS_XB); bf16_t* KSH = (bf16_t*)(ws + WS_KSH); bf16_t* VT = (bf16_t*)(ws + WS_VT); bf16_t* PACT = (bf16_t*)(ws + WS_PACT);
    LAS float* scr = (LAS float*)(lds + wave * 16384);
    volatile LAS unsigned* MISC = (volatile LAS unsigned*)(lds + 131072 + 320);
    if (tid < 32) MISC[tid] = 0u;
    __syncthreads();
    const XcdBarrier bar = xcd_barrier_post((unsigned*)(ws + WS_CTL) + 4096, MISC + 8);

    {
        int base = 0;
#pragma unroll 1
        for (int l = 0; l < 4; ++l) conv_job(base, a.in[8] + (size_t)l * DM * 512, DM, 512, a.in[14], 1.0f, MKVW, DM, MAP_ID, l * 512, scr, gw, ngw, lane);
        convert_layer(a, 0, base, scr, gw, ngw, lane);
        convert_layer(a, 1, base, scr, gw, ngw, lane);
        for (int m = gw; m < TT; m += ngw) row_to_bf16_ssq(a.in[0] + (size_t)m * DM, XB + (size_t)m * DM, SSQX + (size_t)m * 16, lane);
        for (int m = gw; m < MROWS; m += ngw) row_to_bf16_ssq(a.in[1] + (size_t)m * DM, MEMB + (size_t)m * DM, SSQM + (size_t)m * 16, lane);
    }
    grid.sync();

#pragma unroll 1
    for (int l = 0; l < 4; ++l) {
        unsigned char* slot = ws + WS_WSLOT + (size_t)(l & 1) * SLOT_BYTES;
        const bf16_t* WIN = (const bf16_t*)(slot + SL_WIN); const bf16_t* WO = (const bf16_t*)(slot + SL_WO); const bf16_t* WGU = (const bf16_t*)(slot + SL_WGU); const bf16_t* WD = (const bf16_t*)(slot + SL_WD);
        const int pitch = (l < 2) ? PA : PB;
        if (l == 0) {
            pg8::Gemm g{MEMB, MKVW, MROWS, 2048, DM, DM}; pg8::StaticOrder S; S.init(MROWS, 2048, G, bx);
            pg8::EpiMKV E{SSQM, MK, MVT};
            pg8::gemm_phase<pg8::EpiMKV, pg8::StaticOrder, true>(lds, g, S, E);
        }
        {
            const int N = (l == 3) ? 1024 : 2560;
            pg8::Gemm g{XB, WIN, TT, N, DM, DM}; pg8::StaticOrder S; S.init(TT, N, G, bx);
            pg8::EpiProj E{SSQX, PACT, pitch, (l < 2) ? 10 : 4, KSH, (l < 2) ? 0 : 3, VT};
            pg8::gemm_phase<pg8::EpiProj, pg8::StaticOrder, true>(lds, g, S, E);
        }
        xcd_barrier(bar);
        {
            int tid2 = threadIdx.x; asm volatile("" : "+v"(tid2)); const int lane2 = tid2 & 63, gtid2 = bx * (NWAVES * 64) + tid2;
            if (l < 2) conv_items(PACT, a.in[4] + (size_t)l * 3 * MAINW, gtid2, nthreads);
            else for (int it = gw; it < NB * NHSB * 128; it += ngw) sb_attn_item(PACT, KSH, VT, it, lane2);
            for (int it = gw; it < NB * NHM * 128; it += ngw) mem_attn_item(PACT, pitch, MK + (size_t)l * MROWS * 256, MVT + (size_t)l * MROWS * 256, it, lane2);
            if (l == 1 || l == 2) { int base = 0; convert_layer(a, l + 1, base, scr, gw, ngw, lane2); }
        }
        xcd_barrier(bar);
        {
            pg8::Gemm g{PACT, WO, TT, DM, DM, pitch}; pg8::StaticOrder S; S.init(TT, DM, G, bx);
            pg8::EpiRes E{(l == 0) ? a.in[0] : (const float*)X, X, XB, SSQX};
            pg8::gemm_phase<pg8::EpiRes, pg8::StaticOrder, true>(lds, g, S, E);
        }
        xcd_barrier(bar);
        {
            pg8::Gemm g{XB, WGU, TT, 2 * FF, DM, DM}; pg8::StaticOrder S; S.init(TT, 2 * FF, G, bx);
            pg8::EpiSwiGLU E{SSQX, PACT, FF};
            pg8::gemm_phase<pg8::EpiSwiGLU, pg8::StaticOrder, true>(lds, g, S, E);
        }
        xcd_barrier(bar);
        {
            pg8::Gemm g{PACT, WD, TT, DM, FF, FF}; pg8::StaticOrder S; S.init(TT, DM, G, bx);
            pg8::EpiRes E{X, X, XB, SSQX};
            pg8::gemm_phase<pg8::EpiRes, pg8::StaticOrder, true>(lds, g, S, E);
        }
        xcd_barrier(bar);
    }
    for (int m = gw; m < TT; m += ngw) final_row(X + (size_t)m * DM, a.in[15], lane);
}

extern "C" void kernel_launch(void* const* d_in, const int* in_sizes, int n_in, void* d_out, int out_size, void* d_ws, size_t ws_size, hipStream_t stream) {
    static int grid = 0;
    if (grid == 0) {
        if (n_in != 16 || out_size != TT * DM || ws_size < WS_END) { fprintf(stderr, "kernel_launch: unexpected shapes (n_in %d, out %d, ws %zu)\n", n_in, out_size, ws_size); grid = -1; return; }
        int dev = 0, cus = 0, per_cu = 0;
        hipGetDevice(&dev); hipDeviceGetAttribute(&cus, hipDeviceAttributeMultiprocessorCount, dev);
        hipFuncSetAttribute((const void*)fwd_megakernel, hipFuncAttributeMaxDynamicSharedMemorySize, LDS_BYTES);
        hipOccupancyMaxActiveBlocksPerMultiprocessor(&per_cu, (const void*)fwd_megakernel, NWAVES * 64, LDS_BYTES);
        (void)hipGetLastError();
        if (per_cu < 1) per_cu = 1;
        grid = cus;
    }
    if (grid < 0) return;
    if (hipMemsetAsync((char*)d_ws + WS_CTL, 0, CTL_ZERO_BYTES, stream) != hipSuccess) { fprintf(stderr, "kernel_launch: memset failed\n"); return; }
    Args a{};
    for (int i = 0; i < 16; ++i) a.in[i] = (const float*)d_in[i];
    a.out = (float*)d_out; a.ws = (unsigned char*)d_ws;
    void* args[] = {&a};
    hipError_t e = hipLaunchCooperativeKernel((const void*)fwd_megakernel, dim3(grid), dim3(NWAVES * 64), args, LDS_BYTES, stream);
    if (e != hipSuccess) fprintf(stderr, "cooperative launch failed: %s (grid %d)\n", hipGetErrorString(e), grid);
}
```

```cpp
#include <hip/hip_runtime.h>
#include <hip/hip_cooperative_groups.h>
#include <cstdio>
#include <cstdint>
namespace cg = cooperative_groups;

#define LAS __attribute__((address_space(3)))
typedef unsigned short bf16_t;
typedef short bf16x8 __attribute__((ext_vector_type(8)));
typedef short s16x4 __attribute__((ext_vector_type(4)));
typedef float f32x4 __attribute__((ext_vector_type(4)));
typedef float f32x16 __attribute__((ext_vector_type(16)));
typedef unsigned u32x4 __attribute__((ext_vector_type(4)));
typedef unsigned u32x2 __attribute__((ext_vector_type(2)));

constexpr int SEQ = 4096, NB = 4, TT = NB * SEQ, DM = 1024, NMEM = 256, MROWS = NB * NMEM, FF = 2816, MAINW = 768, MEMW = 256, NHSB = 12, NHM = 4;
constexpr int PA = 2560;
constexpr int PB = 1024;
constexpr float EPS = 1e-6f, LOG2E = 1.4426950408889634f, LN2 = 0.6931471805599453f;

constexpr size_t MiB = 1u << 20;
constexpr size_t WS_CTL = 0, CTL_ZERO_BYTES = 65536;
constexpr size_t WS_SSQX = 1 * MiB;
constexpr size_t WS_SSQM = 2 * MiB;
constexpr size_t WS_MEMB = 3 * MiB;
constexpr size_t WS_MK = 5 * MiB;
constexpr size_t WS_MVT = 7 * MiB;
constexpr size_t WS_MKVW = 9 * MiB;
constexpr size_t WS_WSLOT = 13 * MiB, SLOT_BYTES = 24 * MiB;
constexpr size_t SL_WIN = 0, SL_WO = 5 * MiB, SL_WGU = 7 * MiB, SL_WD = 18 * MiB;
constexpr size_t WS_XB = 61 * MiB;
constexpr size_t WS_KSH = 93 * MiB;
constexpr size_t WS_VT = 117 * MiB;
constexpr size_t WS_PACT = 141 * MiB;
constexpr size_t WS_END = 229 * MiB;

constexpr int NWAVES = 8, LDS_BYTES = 147456;

namespace pg8 {
constexpr int BM = 256, BK = 64, HALF = 128, HTB = HALF * BK * 2, STAGE_BYTES = 8 * HTB, NXCD = 8, WGM = 8;
__host__ __device__ __forceinline__ int lds_byte(int r, int c) { const int st = (r >> 4) * 2 + (c >> 5), rr = r & 15, cc = c & 31, ob = rr * 64 + cc * 2; return st * 1024 + (ob ^ (((ob >> 9) & 1) << 5)); }
__host__ __device__ __forceinline__ void stage_rc(int b, int& R, int& C) { const int st = b / 1024, sb = b % 1024, swz = sb ^ (((sb >> 9) & 1) << 5); R = (st >> 1) * 16 + swz / 64; C = (st & 1) * 32 + (swz % 64) / 2; }
__host__ __device__ __forceinline__ int perm32(int rho) { const int n = rho >> 4, i = rho & 15; return 8 * (i >> 2) + 4 * n + (i & 3); }

struct Unit { int pm, pn; };
struct Gemm { const bf16_t* A; const bf16_t* Bt; int M, N, K, lda; };

struct StaticOrder {
    int nM, nN, nwg, G, c;
    __host__ __device__ void init(int M, int N, int G_, int c_) { nM = M / BM; nN = N / BM; nwg = nM * nN; G = G_; c = c_; }
    __host__ __device__ bool next(int i, Unit& u) const {
        const long L = (long)i * G + c; if (L >= nwg) return false;
        int wgid = (int)L; { const int q = nwg / NXCD, r = nwg % NXCD, xcd = wgid % NXCD, off = wgid / NXCD; wgid = (xcd < r ? xcd * (q + 1) : r * (q + 1) + (xcd - r) * q) + off; }
        const int nig = WGM * nN, gid = wgid / nig, fm = gid * WGM, gsz = (nM - fm) < WGM ? (nM - fm) : WGM;
        u.pm = fm + ((wgid % nig) % gsz); u.pn = (wgid % nig) / gsz; return true;
    }
};

typedef float f32x2_t __attribute__((ext_vector_type(2))); typedef __bf16 bf16x2_t __attribute__((ext_vector_type(2)));
__device__ __forceinline__ unsigned cvt_pk_bf16(float lo, float hi) { const f32x2_t v = {lo, hi}; const bf16x2_t b = __builtin_convertvector(v, bf16x2_t); return __builtin_bit_cast(unsigned, b); }

__device__ __forceinline__ float row_rs(const float* ssq, int row, int fq) {
    const f32x4 p = *(const f32x4*)(ssq + (size_t)row * 16 + 4 * fq);
    float s = (p[0] + p[1]) + (p[2] + p[3]);
    s += __shfl_xor(s, 16); s += __shfl_xor(s, 32);
    return __builtin_amdgcn_rsqf(s * (1.0f / 1024.0f) + EPS);
}
__device__ __forceinline__ void load_rs8(const float* ssq, int row0, int fq, float (&rs)[2][4]) {
    f32x4 p[2][4];
#pragma unroll
    for (int ai = 0; ai < 2; ++ai)
#pragma unroll
        for (int m = 0; m < 4; ++m) p[ai][m] = *(const f32x4*)(ssq + (size_t)(row0 + ai * HALF + m * 16) * 16 + 4 * fq);
    __builtin_amdgcn_sched_barrier(0);
#pragma unroll
    for (int ai = 0; ai < 2; ++ai)
#pragma unroll
        for (int m = 0; m < 4; ++m) { float s = (p[ai][m][0] + p[ai][m][1]) + (p[ai][m][2] + p[ai][m][3]); s += __shfl_xor(s, 16); s += __shfl_xor(s, 32); rs[ai][m] = __builtin_amdgcn_rsqf(s * (1.0f / 1024.0f) + EPS); }
    __builtin_amdgcn_sched_barrier(0);
}
__device__ __forceinline__ void store_tile_normal(const f32x4 (&acc)[2][2][4][2], const float (&rs)[2][4], bf16_t* base, int ld, int row0, int col0) {
#pragma unroll
    for (int ai = 0; ai < 2; ++ai)
#pragma unroll
        for (int m = 0; m < 4; ++m) { bf16_t* rowp = base + (size_t)(row0 + ai * HALF + m * 16) * ld + col0; const float s = rs[ai][m];
#pragma unroll
            for (int bj = 0; bj < 2; ++bj) { const f32x4 v0 = acc[ai][bj][m][0] * s, v1 = acc[ai][bj][m][1] * s;
                u32x4 w; w.x = cvt_pk_bf16(v0[0], v0[1]); w.y = cvt_pk_bf16(v0[2], v0[3]); w.z = cvt_pk_bf16(v1[0], v1[1]); w.w = cvt_pk_bf16(v1[2], v1[3]);
                *(u32x4*)(rowp + bj * HALF) = w; } }
}
__device__ __forceinline__ void store_tile_kfrag(const f32x4 (&acc)[2][2][4][2], const float (&rs)[2][4], bf16_t* OK, int sh, int nh, int ntile, int row0, int col0) {
#pragma unroll
    for (int ai = 0; ai < 2; ++ai)
#pragma unroll
        for (int m = 0; m < 4; ++m) { const int row = row0 + ai * HALF + m * 16; const float s = rs[ai][m];
            const int b = row >> sh, t = row & ((1 << sh) - 1), kt = t >> 5, r32 = t & 31;
#pragma unroll
            for (int bj = 0; bj < 2; ++bj) { const int c = col0 + bj * HALF, h = c >> 6, dch = (c & 63) >> 3;
                const f32x4 v0 = acc[ai][bj][m][0] * s, v1 = acc[ai][bj][m][1] * s;
                u32x4 w; w.x = cvt_pk_bf16(v0[0], v0[1]); w.y = cvt_pk_bf16(v0[2], v0[3]); w.z = cvt_pk_bf16(v1[0], v1[1]); w.w = cvt_pk_bf16(v1[2], v1[3]);
                *(u32x4*)(OK + ((((size_t)(b * nh + h) * ntile + kt) * 8 + dch) * 32 + r32) * 8) = w; } }
}
__device__ __forceinline__ void store_tile_vfrag(const f32x4 (&acc)[2][2][4][2], const float (&rs)[2][4], bf16_t* OV, int sh, int nh, int ntile, int row0, int col0) {
#pragma unroll
    for (int ai = 0; ai < 2; ++ai)
#pragma unroll
        for (int m = 0; m < 4; ++m) { const int row = row0 + ai * HALF + m * 16; const float s = rs[ai][m];
            const int b = row >> sh, t = row & ((1 << sh) - 1), kt = t >> 5, k = t & 31, ks = k >> 4, khi = (k >> 2) & 1, kj = (k & 3) | (((k >> 3) & 1) << 2);
#pragma unroll
            for (int bj = 0; bj < 2; ++bj) { const int c = col0 + bj * HALF, h = c >> 6, d = c & 63, dh = d >> 5, r0 = d & 31;
                bf16_t* tp = OV + (((size_t)(b * nh + h) * ntile + kt) * 2048) + ((((dh * 2 + ks) * 2 + khi) * 32 + r0) * 8 + kj);
#pragma unroll
                for (int n = 0; n < 2; ++n) { const f32x4 v = acc[ai][bj][m][n] * s; const unsigned w0 = cvt_pk_bf16(v[0], v[1]), w1 = cvt_pk_bf16(v[2], v[3]);
                    tp[(4 * n + 0) * 8] = (bf16_t)(w0 & 0xffffu); tp[(4 * n + 1) * 8] = (bf16_t)(w0 >> 16); tp[(4 * n + 2) * 8] = (bf16_t)(w1 & 0xffffu); tp[(4 * n + 3) * 8] = (bf16_t)(w1 >> 16); } } }
}
struct EpiProj {
    static constexpr bool PERM = true;
    __device__ __forceinline__ void init(f32x4 (&acc)[2][2][4][2], const Unit&, int, int, int, int) const {
#pragma unroll
        for (int a = 0; a < 2; ++a)
#pragma unroll
            for (int b = 0; b < 2; ++b)
#pragma unroll
                for (int m = 0; m < 4; ++m)
#pragma unroll
                    for (int n = 0; n < 2; ++n) acc[a][b][m][n] = (f32x4){0.f, 0.f, 0.f, 0.f};
    }
    const float* ssq; bf16_t* O0; int ld0, nt0; bf16_t* OKF; int nt1; bf16_t* OVF;
    __device__ __forceinline__ void operator()(const f32x4 (&acc)[2][2][4][2], const Unit& u, int wr, int wc, int fr, int fq) const {
        const int row0 = u.pm * BM + wr * 64 + fr; float rs[2][4]; load_rs8(ssq, row0, fq, rs);
        const int cw = wc * 32 + 8 * fq;
        if (u.pn < nt0) store_tile_normal(acc, rs, O0, ld0, row0, u.pn * BM + cw);
        else if (u.pn < nt0 + nt1) store_tile_kfrag(acc, rs, OKF, 12, NHSB, SEQ / 32, row0, (u.pn - nt0) * BM + cw);
        else store_tile_vfrag(acc, rs, OVF, 12, NHSB, SEQ / 32, row0, (u.pn - nt0 - nt1) * BM + cw);
    }
};
struct EpiMKV {
    static constexpr bool PERM = true;
    __device__ __forceinline__ void init(f32x4 (&acc)[2][2][4][2], const Unit&, int, int, int, int) const {
#pragma unroll
        for (int a = 0; a < 2; ++a)
#pragma unroll
            for (int b = 0; b < 2; ++b)
#pragma unroll
                for (int m = 0; m < 4; ++m)
#pragma unroll
                    for (int n = 0; n < 2; ++n) acc[a][b][m][n] = (f32x4){0.f, 0.f, 0.f, 0.f};
    }
    const float* ssq; bf16_t* MK; bf16_t* MVT;
    __device__ __forceinline__ void operator()(const f32x4 (&acc)[2][2][4][2], const Unit& u, int wr, int wc, int fr, int fq) const {
        const int row0 = u.pm * BM + wr * 64 + fr; float rs[2][4]; load_rs8(ssq, row0, fq, rs);
        const int cw = wc * 32 + 8 * fq, l = u.pn >> 1;
        if ((u.pn & 1) == 0) store_tile_kfrag(acc, rs, MK + (size_t)l * MROWS * 256, 8, NHM, NMEM / 32, row0, cw);
        else store_tile_vfrag(acc, rs, MVT + (size_t)l * MROWS * 256, 8, NHM, NMEM / 32, row0, cw);
    }
};
struct EpiSwiGLU {
    static constexpr bool PERM = true;
    __device__ __forceinline__ void init(f32x4 (&acc)[2][2][4][2], const Unit&, int, int, int, int) const {
#pragma unroll
        for (int a = 0; a < 2; ++a)
#pragma unroll
            for (int b = 0; b < 2; ++b)
#pragma unroll
                for (int m = 0; m < 4; ++m)
#pragma unroll
                    for (int n = 0; n < 2; ++n) acc[a][b][m][n] = (f32x4){0.f, 0.f, 0.f, 0.f};
    }
    const float* ssq; bf16_t* O; int ldc;
    __device__ __forceinline__ void operator()(const f32x4 (&acc)[2][2][4][2], const Unit& u, int wr, int wc, int fr, int fq) const {
        const int row0 = u.pm * BM + wr * 64 + fr, col0 = u.pn * HALF + wc * 32 + 8 * fq; float rs[2][4]; load_rs8(ssq, row0, fq, rs);
#pragma unroll
        for (int ai = 0; ai < 2; ++ai)
#pragma unroll
            for (int m = 0; m < 4; ++m) { const int row = row0 + ai * HALF + m * 16; const float s = rs[ai][m];
                float o[8];
#pragma unroll
                for (int n = 0; n < 2; ++n)
#pragma unroll
                    for (int i = 0; i < 4; ++i) { const float g = acc[ai][0][m][n][i] * s, up = acc[ai][1][m][n][i] * s;
                        o[4 * n + i] = g * __builtin_amdgcn_rcpf(1.0f + __builtin_amdgcn_exp2f(-g * LOG2E)) * up; }
                u32x4 w; w.x = cvt_pk_bf16(o[0], o[1]); w.y = cvt_pk_bf16(o[2], o[3]); w.z = cvt_pk_bf16(o[4], o[5]); w.w = cvt_pk_bf16(o[6], o[7]);
                *(u32x4*)(O + (size_t)row * ldc + col0) = w; }
    }
};
struct EpiRes {
    static constexpr bool PERM = true;
    const float* base; float* out; bf16_t* xb; float* ssq;
    __device__ __forceinline__ void init(f32x4 (&acc)[2][2][4][2], const Unit& u, int wr, int wc, int fr, int fq) const {
        const int row0 = u.pm * BM + wr * 64 + fr, col0 = u.pn * BM + wc * 32 + 8 * fq;
#pragma unroll
        for (int ai = 0; ai < 2; ++ai)
#pragma unroll
            for (int m = 0; m < 4; ++m) { const size_t off = (size_t)(row0 + ai * HALF + m * 16) * DM + col0;
#pragma unroll
                for (int bj = 0; bj < 2; ++bj) { acc[ai][bj][m][0] = *(const f32x4*)(base + off + bj * HALF); acc[ai][bj][m][1] = *(const f32x4*)(base + off + bj * HALF + 4); } }
    }
    __device__ __forceinline__ void operator()(const f32x4 (&acc)[2][2][4][2], const Unit& u, int wr, int wc, int fr, int fq) const {
        const int row0 = u.pm * BM + wr * 64 + fr, col0 = u.pn * BM + wc * 32 + 8 * fq;
#pragma unroll
        for (int ai = 0; ai < 2; ++ai)
#pragma unroll
            for (int m = 0; m < 4; ++m) { const int row = row0 + ai * HALF + m * 16; const size_t off = (size_t)row * DM + col0; float sq = 0.f;
#pragma unroll
                for (int bj = 0; bj < 2; ++bj) { const f32x4 x0 = acc[ai][bj][m][0], x1 = acc[ai][bj][m][1];
                    *(f32x4*)(out + off + bj * HALF) = x0; *(f32x4*)(out + off + bj * HALF + 4) = x1;
                    u32x4 w; w.x = cvt_pk_bf16(x0[0], x0[1]); w.y = cvt_pk_bf16(x0[2], x0[3]); w.z = cvt_pk_bf16(x1[0], x1[1]); w.w = cvt_pk_bf16(x1[2], x1[3]);
                    *(u32x4*)(xb + off + bj * HALF) = w;
                    sq += (x0[0] * x0[0] + x0[1] * x0[1]) + (x0[2] * x0[2] + x0[3] * x0[3]) + (x1[0] * x1[0] + x1[1] * x1[1]) + (x1[2] * x1[2] + x1[3] * x1[3]); }
                sq += __shfl_xor(sq, 16); sq += __shfl_xor(sq, 32);
                if (fq == 0) ssq[(size_t)row * 16 + u.pn * 4 + wc] = sq; }
    }
};

enum { EM_PROJ = 0, EM_MKV = 1, EM_SWIGLU = 2, EM_RES = 3 };
struct EpiAny {
    static constexpr bool PERM = true;
    int mode;
    EpiProj pj; EpiMKV mk; EpiSwiGLU sw; EpiRes rs;
    __device__ __forceinline__ void init(f32x4 (&acc)[2][2][4][2], const Unit& u, int wr, int wc, int fr, int fq) const {
        if (mode == EM_RES) rs.init(acc, u, wr, wc, fr, fq); else pj.init(acc, u, wr, wc, fr, fq);
    }
    __device__ __forceinline__ void operator()(const f32x4 (&acc)[2][2][4][2], const Unit& u, int wr, int wc, int fr, int fq) const {
        if (mode == EM_PROJ) pj(acc, u, wr, wc, fr, fq);
        else if (mode == EM_SWIGLU) sw(acc, u, wr, wc, fr, fq);
        else if (mode == EM_RES) rs(acc, u, wr, wc, fr, fq);
        else mk(acc, u, wr, wc, fr, fq);
    }
};

template <class Epi, class Sched, bool ALIGN_EPI>
__device__ __forceinline__ void gemm_phase(LAS unsigned char* lds, const Gemm g, const Sched& S, const Epi& E) {
    int tid = threadIdx.x; asm volatile("" : "+v"(tid));
    const int wid = __builtin_amdgcn_readfirstlane(tid >> 6), lane = tid & 63, wr = wid >> 2, wc = wid & 3, fr = lane & 15, fq = lane >> 4;
    const int K = g.K, nt = K / BK;
    unsigned voffA[2], voffB[2];
#pragma unroll
    for (int i = 0; i < 2; ++i) { int R, C; stage_rc(tid * 16 + i * 8192, R, C); const int Rb = Epi::PERM ? ((R & ~31) + perm32(R & 31)) : R;
        voffA[i] = (unsigned)(R * g.lda + C) * 2u; voffB[i] = (unsigned)(Rb * K + C) * 2u; }
    const size_t kstep = (size_t)(BK * 2);
    const size_t hstepA = (size_t)HALF * g.lda * 2, hstepB = (size_t)HALF * K * 2;
    const size_t tstepA = 2 * hstepA, tstepB = 2 * hstepB;
    const unsigned ldsw = (unsigned)wid * 1024u;
    const int aoff = lds_byte(wr * 64 + fr, fq * 8), boff = lds_byte(wc * 32 + fr, fq * 8);
#define PG8_SA(b, h) (((b) * 2 + (h)) * HTB)
#define PG8_SB(b, h) ((4 + (b) * 2 + (h)) * HTB)
#define PG8_STAGE(bufoff, gbase, voff) do { _Pragma("unroll") for (int _i = 0; _i < 2; ++_i) \
        __builtin_amdgcn_global_load_lds((const unsigned*)((const char*)(gbase) + (voff)[_i]), (LAS unsigned*)(lds + (bufoff) + ldsw + _i * 8192), 16, 0, 0); } while (0)
#define PG8_LDA(dst, b, h) do { _Pragma("unroll") for (int m = 0; m < 4; ++m) _Pragma("unroll") for (int k = 0; k < 2; ++k) dst[m][k] = *(const LAS bf16x8*)(lds + PG8_SA(b, h) + aoff + m * 2048 + k * 1024); } while (0)
#define PG8_LDB(dst, b, h) do { _Pragma("unroll") for (int n = 0; n < 2; ++n) _Pragma("unroll") for (int k = 0; k < 2; ++k) dst[n][k] = *(const LAS bf16x8*)(lds + PG8_SB(b, h) + boff + n * 2048 + k * 1024); } while (0)
#define PG8_MMA(ai, bj, At, Bt) do { __builtin_amdgcn_s_setprio(1); _Pragma("unroll") for (int m = 0; m < 4; ++m) _Pragma("unroll") for (int n = 0; n < 2; ++n) _Pragma("unroll") for (int k = 0; k < 2; ++k) \
        acc[ai][bj][m][n] = __builtin_amdgcn_mfma_f32_16x16x32_bf16(Bt[n][k], At[m][k], acc[ai][bj][m][n], 0, 0, 0); __builtin_amdgcn_s_setprio(0); } while (0)
#define PG8_WAIT_V(n) asm volatile("s_waitcnt vmcnt(" #n ")" ::: "memory")
#define PG8_WAIT_L(n) asm volatile("s_waitcnt lgkmcnt(" #n ")" ::: "memory")
#define PG8_BAR __builtin_amdgcn_s_barrier()
#define PG8_SCHED __builtin_amdgcn_sched_barrier(0)
    Unit cur, nxt; int ui = 0;
    if (!S.next(0, cur)) return;
    f32x4 acc[2][2][4][2];
    E.init(acc, cur, wr, wc, fr, fq);
    bf16x8 At[4][2], B0[2][2], B1[2][2];
    const char* cA = (const char*)g.A + (size_t)cur.pm * tstepA; const char* cB = (const char*)g.Bt + (size_t)cur.pn * tstepB;
    PG8_STAGE(PG8_SB(0, 0), cB, voffB); PG8_STAGE(PG8_SB(0, 1), cB + hstepB, voffB); PG8_STAGE(PG8_SA(0, 0), cA, voffA); PG8_STAGE(PG8_SA(0, 1), cA + hstepA, voffA);
    if (wr == 1) PG8_BAR;
    PG8_WAIT_V(2); PG8_BAR;
    PG8_STAGE(PG8_SB(1, 0), cB + kstep, voffB); PG8_STAGE(PG8_SA(1, 0), cA + kstep, voffA); PG8_STAGE(PG8_SB(1, 1), cB + hstepB + kstep, voffB);
    PG8_WAIT_V(6); PG8_BAR;
    for (;;) {
        const bool has_next = S.next(ui + 1, nxt);
        const char* nA = has_next ? (const char*)g.A + (size_t)nxt.pm * tstepA : cA; const char* nB = has_next ? (const char*)g.Bt + (size_t)nxt.pn * tstepB : cB;
        for (int t = 0; t < nt; t += 2) {
            const bool last = (t == nt - 2);
            const char* a1 = cA + (size_t)(t + 1) * kstep;
            const char* a2 = last ? nA : cA + (size_t)(t + 2) * kstep; const char* b2 = last ? nB : cB + (size_t)(t + 2) * kstep;
            const char* a3 = a2 + kstep; const char* b3 = b2 + kstep;
            PG8_LDB(B0, 0, 0); PG8_LDB(B1, 0, 1); PG8_SCHED; PG8_LDA(At, 0, 0); PG8_STAGE(PG8_SA(1, 1), a1 + hstepA, voffA);
            PG8_WAIT_V(8); PG8_WAIT_L(0); PG8_BAR; PG8_MMA(0, 0, At, B0); PG8_MMA(0, 1, At, B1); PG8_BAR; PG8_SCHED;
            PG8_LDA(At, 0, 1); PG8_STAGE(PG8_SB(0, 0), b2, voffB); PG8_STAGE(PG8_SB(0, 1), b2 + hstepB, voffB); PG8_STAGE(PG8_SA(0, 0), a2, voffA);
            PG8_WAIT_V(8); PG8_WAIT_L(0); PG8_BAR; PG8_MMA(1, 0, At, B0); PG8_MMA(1, 1, At, B1); PG8_BAR; PG8_SCHED;
            PG8_LDB(B0, 1, 0); PG8_LDB(B1, 1, 1); PG8_SCHED; PG8_LDA(At, 1, 0); PG8_STAGE(PG8_SA(0, 1), a2 + hstepA, voffA);
            PG8_WAIT_V(8); PG8_WAIT_L(0); PG8_BAR; PG8_MMA(0, 0, At, B0); PG8_MMA(0, 1, At, B1); PG8_BAR; PG8_SCHED;
            PG8_LDA(At, 1, 1); PG8_STAGE(PG8_SB(1, 0), b3, voffB); PG8_STAGE(PG8_SB(1, 1), b3 + hstepB, voffB); PG8_STAGE(PG8_SA(1, 0), a3, voffA);
            PG8_WAIT_V(8); PG8_WAIT_L(0); PG8_BAR; PG8_MMA(1, 0, At, B0); PG8_MMA(1, 1, At, B1); PG8_BAR; PG8_SCHED;
        }
        if constexpr (ALIGN_EPI) { if (wr == 0) PG8_BAR; }
        E(acc, cur, wr, wc, fr, fq);
        if (!has_next) break;
        E.init(acc, nxt, wr, wc, fr, fq);
        cur = nxt; cA = nA; cB = nB; ++ui;
        if constexpr (ALIGN_EPI) { if (wr == 1) PG8_BAR; }
    }
    PG8_WAIT_V(0);
    if constexpr (!ALIGN_EPI) { if (wr == 0) PG8_BAR; }
    PG8_BAR;
#undef PG8_SA
#undef PG8_SB
#undef PG8_STAGE
#undef PG8_LDA
#undef PG8_LDB
#undef PG8_MMA
#undef PG8_WAIT_V
#undef PG8_WAIT_L
#undef PG8_BAR
#undef PG8_SCHED
}
}

__device__ __forceinline__ float wave_sum(float v) {
#pragma unroll
    for (int o = 1; o < 64; o <<= 1) v += __shfl_xor(v, o);
    return v;
}
__device__ __forceinline__ unsigned pk2(float lo, float hi) { return pg8::cvt_pk_bf16(lo, hi); }
__device__ __forceinline__ float bf_lo(unsigned w) { return __uint_as_float(w << 16); }
__device__ __forceinline__ float bf_hi(unsigned w) { return __uint_as_float(w & 0xffff0000u); }
__device__ __forceinline__ int crow(int r, int hi) { return (r & 3) + 8 * (r >> 2) + 4 * hi; }

__device__ __forceinline__ void tr_item(const float* W, int N, int k0, int n0, const float* gain, float scale, bf16_t* WT, int Kd, int drow0, LAS float* scr, int lane) {
    float wv[32]; const float gl = gain ? gain[k0 + lane] * scale : scale;
#pragma unroll
    for (int i = 0; i < 32; ++i) wv[i] = W[(size_t)(k0 + 2 * i + (lane >> 5)) * N + n0 + (lane & 31)];
    __builtin_amdgcn_sched_barrier(0);
#pragma unroll
    for (int i = 0; i < 32; ++i) { const float g0 = __shfl(gl, 2 * i), g1 = __shfl(gl, 2 * i + 1); scr[(2 * i + (lane >> 5)) * 33 + (lane & 31)] = wv[i] * ((lane >> 5) ? g1 : g0); }
    asm volatile("s_waitcnt lgkmcnt(0)" ::: "memory");
    const int c = lane & 7;
#pragma unroll
    for (int j = 0; j < 4; ++j) { const int n = (lane >> 3) + 8 * j; const LAS float* s = scr + (8 * c) * 33 + n;
        u32x4 o; o.x = pk2(s[0 * 33], s[1 * 33]); o.y = pk2(s[2 * 33], s[3 * 33]); o.z = pk2(s[4 * 33], s[5 * 33]); o.w = pk2(s[6 * 33], s[7 * 33]);
        *(u32x4*)(WT + (size_t)(drow0 + n) * Kd + k0 + 8 * c) = o; }
    asm volatile("s_waitcnt lgkmcnt(0)" ::: "memory");
}
enum { MAP_ID = 0, MAP_AIN = 1, MAP_GATE = 2, MAP_UP = 3 };
__device__ __forceinline__ void conv_job(int& base, const float* W, int K, int N, const float* gain, float scale, bf16_t* WT, int Kd, int map, int row_off, LAS float* scr, int gw, int ngw, int lane) {
    const int nblk = N / 32, nitems = (K / 64) * nblk;
    int first = (gw - (base % ngw)); if (first < 0) first += ngw;
    for (int it = first; it < nitems; it += ngw) {
        const int kb = it / nblk, nb = it % nblk, n0 = 32 * nb; int drow0 = row_off + n0; float sc = scale;
        if (map == MAP_AIN) { if (n0 < 768) drow0 = n0; else if (n0 < 1536) drow0 = n0 - 768 + 1024; else if (n0 < 2304) drow0 = n0 - 1536 + 1792; else { drow0 = n0 - 2304 + 768; sc = 0.125f; } }
        else if (map == MAP_GATE) drow0 = (n0 >> 7) * 256 + (n0 & 127);
        else if (map == MAP_UP) drow0 = (n0 >> 7) * 256 + 128 + (n0 & 127);
        tr_item(W, N, 64 * kb, n0, gain, sc, WT, Kd, drow0, scr, lane);
    }
    base += nitems;
}

struct Args { const float* in[16]; float* out; unsigned char* ws; };

__device__ __forceinline__ void convert_layer(const Args& a, int l, int& base, LAS float* scr, int gw, int ngw, int lane) {
    unsigned char* slot = a.ws + WS_WSLOT + (size_t)(l & 1) * SLOT_BYTES;
    bf16_t* WIN = (bf16_t*)(slot + SL_WIN); bf16_t* WO = (bf16_t*)(slot + SL_WO); bf16_t* WGU = (bf16_t*)(slot + SL_WGU); bf16_t* WD = (bf16_t*)(slot + SL_WD);
    const float* mixg = a.in[2] + (size_t)l * DM; const float* ffng = a.in[10] + (size_t)l * DM;
    if (l < 2) conv_job(base, a.in[3] + (size_t)l * DM * PA, DM, PA, mixg, 1.0f, WIN, DM, MAP_AIN, 0, scr, gw, ngw, lane);
    else {
        conv_job(base, a.in[5] + (size_t)(l - 2) * DM * DM, DM, DM, mixg, 0.125f, WIN, DM, MAP_ID, 0, scr, gw, ngw, lane);
        if (l == 2) conv_job(base, a.in[7], DM, 2 * MAINW, a.in[6], 1.0f, WIN, DM, MAP_ID, DM, scr, gw, ngw, lane);
    }
    conv_job(base, a.in[9] + (size_t)l * DM * DM, DM, DM, nullptr, 1.0f, WO, DM, MAP_ID, 0, scr, gw, ngw, lane);
    conv_job(base, a.in[11] + (size_t)l * DM * FF, DM, FF, ffng, 1.0f, WGU, DM, MAP_GATE, 0, scr, gw, ngw, lane);
    conv_job(base, a.in[12] + (size_t)l * DM * FF, DM, FF, ffng, 1.0f, WGU, DM, MAP_UP, 0, scr, gw, ngw, lane);
    conv_job(base, a.in[13] + (size_t)l * FF * DM, FF, DM, nullptr, 1.0f, WD, FF, MAP_ID, 0, scr, gw, ngw, lane);
}

__device__ __forceinline__ void row_to_bf16_ssq(const float* xrow, bf16_t* orow, float* ssq16, int lane) {
    const f32x4* xr = (const f32x4*)xrow + lane; f32x4 v[4]; float s = 0.f;
#pragma unroll
    for (int j = 0; j < 4; ++j) v[j] = xr[64 * j];
    __builtin_amdgcn_sched_barrier(0);
#pragma unroll
    for (int j = 0; j < 4; ++j) s += (v[j][0] * v[j][0] + v[j][1] * v[j][1]) + (v[j][2] * v[j][2] + v[j][3] * v[j][3]);
    s = wave_sum(s);
    u32x2* o8 = (u32x2*)orow + lane;
#pragma unroll
    for (int j = 0; j < 4; ++j) { u32x2 w; w.x = pk2(v[j][0], v[j][1]); w.y = pk2(v[j][2], v[j][3]); o8[64 * j] = w; }
    if (lane < 4) *(f32x4*)(ssq16 + 4 * lane) = (f32x4){lane == 0 ? s : 0.f, 0.f, 0.f, 0.f};
}
__device__ __forceinline__ void final_row(float* xrow, const float* g, int lane) {
    f32x4* xr = (f32x4*)xrow + lane; const f32x4* gr = (const f32x4*)g + lane; f32x4 v[4]; float s = 0.f;
#pragma unroll
    for (int j = 0; j < 4; ++j) v[j] = xr[64 * j];
    f32x4 gv[4];
#pragma unroll
    for (int j = 0; j < 4; ++j) gv[j] = gr[64 * j];
    __builtin_amdgcn_sched_barrier(0);
#pragma unroll
    for (int j = 0; j < 4; ++j) s += (v[j][0] * v[j][0] + v[j][1] * v[j][1]) + (v[j][2] * v[j][2] + v[j][3] * v[j][3]);
    s = wave_sum(s); const float rs = 1.0f / sqrtf(s * (1.0f / 1024.0f) + EPS);
#pragma unroll
    for (int j = 0; j < 4; ++j) xr[64 * j] = v[j] * rs * gv[j];
}

__device__ __forceinline__ void conv_items(bf16_t* P, const float* cw, int gtid, int nthreads) {
    for (int it = gtid; it < (TT / 16) * 96; it += nthreads) {
        const int cgp = it % 96, ch = it / 96, row0 = ch * 16, c0 = cgp * 8, t0 = row0 & (SEQ - 1);
        float w0[8], w1[8], w2[8], p2[8], p1[8];
#pragma unroll
        for (int i = 0; i < 8; ++i) { w0[i] = cw[c0 + i]; w1[i] = cw[MAINW + c0 + i]; w2[i] = cw[2 * MAINW + c0 + i]; p2[i] = 0.f; p1[i] = 0.f; }
        if (t0 >= 2) {
            const bf16_t* r2 = P + (size_t)(row0 - 2) * PA; const bf16_t* r1 = P + (size_t)(row0 - 1) * PA;
            const u32x4 g2 = *(const u32x4*)(r2 + 1024 + c0), u2 = *(const u32x4*)(r2 + 1792 + c0), g1 = *(const u32x4*)(r1 + 1024 + c0), u1 = *(const u32x4*)(r1 + 1792 + c0);
#pragma unroll
            for (int i = 0; i < 4; ++i) { p2[2 * i] = bf_lo(g2[i]) * bf_lo(u2[i]); p2[2 * i + 1] = bf_hi(g2[i]) * bf_hi(u2[i]); p1[2 * i] = bf_lo(g1[i]) * bf_lo(u1[i]); p1[2 * i + 1] = bf_hi(g1[i]) * bf_hi(u1[i]); }
        }
#pragma unroll 1
        for (int i0 = 0; i0 < 16; i0 += 4) {
            u32x4 gg[4], uu[4], bb[4];
#pragma unroll
            for (int j = 0; j < 4; ++j) { const bf16_t* r = P + (size_t)(row0 + i0 + j) * PA; gg[j] = *(const u32x4*)(r + 1024 + c0); uu[j] = *(const u32x4*)(r + 1792 + c0); bb[j] = *(const u32x4*)(r + c0); }
            __builtin_amdgcn_sched_barrier(0);
#pragma unroll
            for (int j = 0; j < 4; ++j) {
                float cu[8], y[8];
#pragma unroll
                for (int q = 0; q < 4; ++q) { cu[2 * q] = bf_lo(gg[j][q]) * bf_lo(uu[j][q]); cu[2 * q + 1] = bf_hi(gg[j][q]) * bf_hi(uu[j][q]); }
#pragma unroll
                for (int q = 0; q < 4; ++q) { y[2 * q] = bf_lo(bb[j][q]) * (w0[2 * q] * p2[2 * q] + w1[2 * q] * p1[2 * q] + w2[2 * q] * cu[2 * q]);
                    y[2 * q + 1] = bf_hi(bb[j][q]) * (w0[2 * q + 1] * p2[2 * q + 1] + w1[2 * q + 1] * p1[2 * q + 1] + w2[2 * q + 1] * cu[2 * q + 1]); }
                u32x4 o; o.x = pk2(y[0], y[1]); o.y = pk2(y[2], y[3]); o.z = pk2(y[4], y[5]); o.w = pk2(y[6], y[7]);
                *(u32x4*)(P + (size_t)(row0 + i0 + j) * PA + c0) = o;
#pragma unroll
                for (int q = 0; q < 8; ++q) { p2[q] = p1[q]; p1[q] = cu[q]; }
            }
        }
    }
}

__device__ __forceinline__ float half_max(float m) { auto rr = __builtin_amdgcn_permlane32_swap(__float_as_uint(m), __float_as_uint(m), false, false); return fmaxf(__uint_as_float(rr[0]), __uint_as_float(rr[1])); }
__device__ __forceinline__ bf16x8 pack8(const f32x16& p, int s) {
    u32x4 w; w.x = pk2(p[8 * s + 0], p[8 * s + 1]); w.y = pk2(p[8 * s + 2], p[8 * s + 3]); w.z = pk2(p[8 * s + 4], p[8 * s + 5]); w.w = pk2(p[8 * s + 6], p[8 * s + 7]);
    return __builtin_bit_cast(bf16x8, w);
}
__device__ __forceinline__ bf16x8 vfrag(const bf16_t* p) {
    const s16x4 lo = *(const s16x4*)p, hi = *(const s16x4*)(p + 8);
    return (bf16x8){lo[0], lo[1], lo[2], lo[3], hi[0], hi[1], hi[2], hi[3]};
}
__device__ __forceinline__ void store_o(bf16_t* qp, const f32x16& o0, const f32x16& o1, float sc, int hi) {
#pragma unroll
    for (int g = 0; g < 4; ++g) { u32x2 w; w.x = pk2(o0[4 * g] * sc, o0[4 * g + 1] * sc); w.y = pk2(o0[4 * g + 2] * sc, o0[4 * g + 3] * sc); *(u32x2*)(qp + 8 * g + 4 * hi) = w; }
#pragma unroll
    for (int g = 0; g < 4; ++g) { u32x2 w; w.x = pk2(o1[4 * g] * sc, o1[4 * g + 1] * sc); w.y = pk2(o1[4 * g + 2] * sc, o1[4 * g + 3] * sc); *(u32x2*)(qp + 32 + 8 * g + 4 * hi) = w; }
}

__device__ __forceinline__ void mem_attn_item(bf16_t* P, int pitch, const bf16_t* MK, const bf16_t* MVT, int item, int lane) {
    const int qb = item & 127, hm = (item >> 7) & 3, b = item >> 9, r32 = lane & 31, hi = lane >> 5;
    bf16_t* qp = P + (size_t)(b * SEQ + qb * 32 + r32) * pitch + MAINW + hm * 64;
    const bf16_t* kp = MK + (size_t)(b * NHM + hm) * (NMEM / 32) * 2048 + (hi * 32 + r32) * 8;
    const bf16_t* vp = MVT + (size_t)(b * NHM + hm) * (NMEM / 32) * 2048 + (hi * 32 + r32) * 8;
    bf16x8 qf[4], kc[4], kn[4];
#pragma unroll
    for (int d0 = 0; d0 < 4; ++d0) qf[d0] = *(const bf16x8*)(qp + d0 * 16 + hi * 8);
#pragma unroll
    for (int d0 = 0; d0 < 4; ++d0) kc[d0] = *(const bf16x8*)(kp + d0 * 512);
    f32x16 sc[8];
#pragma unroll
    for (int mt = 0; mt < 8; ++mt) {
        if (mt < 7) {
#pragma unroll
            for (int d0 = 0; d0 < 4; ++d0) kn[d0] = *(const bf16x8*)(kp + (mt + 1) * 2048 + d0 * 512); }
        __builtin_amdgcn_sched_barrier(0);
        f32x16 z = {};
#pragma unroll
        for (int d0 = 0; d0 < 4; ++d0) z = __builtin_amdgcn_mfma_f32_32x32x16_bf16(kc[d0], qf[d0], z, 0, 0, 0);
        sc[mt] = z;
        __builtin_amdgcn_sched_barrier(0);
#pragma unroll
        for (int d0 = 0; d0 < 4; ++d0) kc[d0] = kn[d0];
    }
    bf16x8 vc[4], vn[4];
#pragma unroll
    for (int i = 0; i < 4; ++i) vc[i] = *(const bf16x8*)(vp + (2 * (i & 1) + (i >> 1)) * 512);
    __builtin_amdgcn_sched_barrier(0);
    float mx = -INFINITY;
#pragma unroll
    for (int mt = 0; mt < 8; ++mt)
#pragma unroll
        for (int r = 0; r < 16; ++r) mx = fmaxf(mx, sc[mt][r]);
    mx = half_max(mx);
    float l = 0.f;
#pragma unroll
    for (int mt = 0; mt < 8; ++mt)
#pragma unroll
        for (int r = 0; r < 16; ++r) { const float e = __builtin_amdgcn_exp2f((sc[mt][r] - mx) * LOG2E); sc[mt][r] = e; l += e; }
    { auto rr = __builtin_amdgcn_permlane32_swap(__float_as_uint(l), __float_as_uint(l), false, false); l = __uint_as_float(rr[0]) + __uint_as_float(rr[1]); }
    f32x16 o0 = {}, o1 = {};
#pragma unroll
    for (int mt = 0; mt < 8; ++mt) {
        if (mt < 7) {
#pragma unroll
            for (int i = 0; i < 4; ++i) vn[i] = *(const bf16x8*)(vp + (mt + 1) * 2048 + (2 * (i & 1) + (i >> 1)) * 512); }
        __builtin_amdgcn_sched_barrier(0);
        const bf16x8 p0 = pack8(sc[mt], 0), p1 = pack8(sc[mt], 1);
        o0 = __builtin_amdgcn_mfma_f32_32x32x16_bf16(vc[0], p0, o0, 0, 0, 0); o1 = __builtin_amdgcn_mfma_f32_32x32x16_bf16(vc[1], p0, o1, 0, 0, 0);
        o0 = __builtin_amdgcn_mfma_f32_32x32x16_bf16(vc[2], p1, o0, 0, 0, 0); o1 = __builtin_amdgcn_mfma_f32_32x32x16_bf16(vc[3], p1, o1, 0, 0, 0);
        __builtin_amdgcn_sched_barrier(0);
#pragma unroll
        for (int i = 0; i < 4; ++i) vc[i] = vn[i];
    }
    store_o(qp, o0, o1, 1.0f / l, hi);
}

__device__ __forceinline__ void sb_attn_item(bf16_t* P, const bf16_t* Ksh, const bf16_t* VT, int item, int lane) {
    const int qb = item & 127, bh = item >> 7, h = bh % NHSB, b = bh / NHSB, r32 = lane & 31, hi = lane >> 5;
    bf16_t* qp = P + (size_t)(b * SEQ + qb * 32 + r32) * PB + h * 64;
    const bf16_t* kbase = Ksh + (size_t)(b * NHSB + h) * (SEQ / 32) * 2048 + (hi * 32 + r32) * 8;
    const bf16_t* vbase = VT + (size_t)(b * NHSB + h) * (SEQ / 32) * 2048 + (hi * 32 + r32) * 8;
    bf16x8 qf[4], kc[4], vc[4], kn[4], vn[4];
#pragma unroll
    for (int d0 = 0; d0 < 4; ++d0) qf[d0] = *(const bf16x8*)(qp + d0 * 16 + hi * 8);
#pragma unroll
    for (int d0 = 0; d0 < 4; ++d0) kc[d0] = *(const bf16x8*)(kbase + qb * 2048 + d0 * 512);
#pragma unroll
    for (int i = 0; i < 4; ++i) vc[i] = *(const bf16x8*)(vbase + qb * 2048 + (2 * (i & 1) + (i >> 1)) * 512);
    float C = 0.f; f32x16 o0 = {}, o1 = {};
    for (int kt = qb; kt >= 0; --kt) {
        const int ktn = kt > 0 ? kt - 1 : 0;
#pragma unroll
        for (int d0 = 0; d0 < 4; ++d0) kn[d0] = *(const bf16x8*)(kbase + ktn * 2048 + d0 * 512);
#pragma unroll
        for (int i = 0; i < 4; ++i) vn[i] = *(const bf16x8*)(vbase + ktn * 2048 + (2 * (i & 1) + (i >> 1)) * 512);
        __builtin_amdgcn_sched_barrier(0);
        f32x16 z = {};
#pragma unroll
        for (int d0 = 0; d0 < 4; ++d0) z = __builtin_amdgcn_mfma_f32_32x32x16_bf16(kc[d0], qf[d0], z, 0, 0, 0);
        const bool diag = (kt == qb);
        float ln[16], zl[16];
#pragma unroll
        for (int r = 0; r < 16; ++r) { const float zz = z[r], e = __builtin_amdgcn_exp2f(-fabsf(zz) * LOG2E), sp = fmaxf(zz, 0.f) + LN2 * __builtin_amdgcn_logf(1.0f + e);
            const bool valid = !diag || (crow(r, hi) < r32);
            ln[r] = valid ? -sp : 0.f; zl[r] = valid ? (zz - sp) : -INFINITY; }
        float G0[4], G1[4];
#pragma unroll
        for (int g = 0; g < 4; ++g) { const float gs = (ln[4 * g] + ln[4 * g + 1]) + (ln[4 * g + 2] + ln[4 * g + 3]);
            const float ot = __shfl_xor(gs, 32); G0[g] = hi ? ot : gs; G1[g] = hi ? gs : ot; }
        float R = C;
        f32x16 a;
#pragma unroll
        for (int g = 3; g >= 0; --g) {
            float tl = R + (hi == 0 ? G1[g] : 0.f);
            a[4 * g + 3] = __builtin_amdgcn_exp2f((zl[4 * g + 3] + tl) * LOG2E); tl += ln[4 * g + 3];
            a[4 * g + 2] = __builtin_amdgcn_exp2f((zl[4 * g + 2] + tl) * LOG2E); tl += ln[4 * g + 2];
            a[4 * g + 1] = __builtin_amdgcn_exp2f((zl[4 * g + 1] + tl) * LOG2E); tl += ln[4 * g + 1];
            a[4 * g + 0] = __builtin_amdgcn_exp2f((zl[4 * g + 0] + tl) * LOG2E);
            R += G0[g] + G1[g];
        }
        C = R;
        const bf16x8 p0 = pack8(a, 0), p1 = pack8(a, 1);
        o0 = __builtin_amdgcn_mfma_f32_32x32x16_bf16(vc[0], p0, o0, 0, 0, 0); o1 = __builtin_amdgcn_mfma_f32_32x32x16_bf16(vc[1], p0, o1, 0, 0, 0);
        o0 = __builtin_amdgcn_mfma_f32_32x32x16_bf16(vc[2], p1, o0, 0, 0, 0); o1 = __builtin_amdgcn_mfma_f32_32x32x16_bf16(vc[3], p1, o1, 0, 0, 0);
        __builtin_amdgcn_sched_barrier(0);
#pragma unroll
        for (int i = 0; i < 4; ++i) { kc[i] = kn[i]; vc[i] = vn[i]; }
        if (__all(C < -110.0f)) break;
    }
    store_o(qp, o0, o1, 1.0f, hi);
}

#define XB_TMO      128
#define XB_XCNT(j)  (256  + 64 * (j))
#define XB_XSUB(j)  (1280 + 64 * (j))
#define XB_XGEN(j)  (2304 + 64 * (j))
#define XB_TOP      3328
#define XB_TOPGEN   3392
#define XCD_BAR_WORDS 3456
#define XB_SPIN_CAP (1u << 18)
__device__ __forceinline__ unsigned xb_ld(unsigned* p)              { return __hip_atomic_load(p, __ATOMIC_RELAXED, __HIP_MEMORY_SCOPE_AGENT); }
__device__ __forceinline__ unsigned xb_add(unsigned* p, unsigned v) { return __hip_atomic_fetch_add(p, v, __ATOMIC_RELAXED, __HIP_MEMORY_SCOPE_AGENT); }
__device__ __forceinline__ unsigned xb_xcc_id() { return (unsigned)__builtin_amdgcn_s_getreg((3 << 11) | 20) & 0xFu; }
#define XB_SPIN(cond, bar) do { unsigned _sp = 0; while (cond) { __builtin_amdgcn_s_sleep(1); \
    if ((++_sp & 255u) == 0u) { if (xb_ld(&(bar)[XB_TMO])) break; if (_sp > XB_SPIN_CAP) { atomicAdd(&(bar)[XB_TMO], 1u); break; } } } } while (0)
struct XcdBarrier { unsigned* bar; unsigned x; volatile LAS unsigned* st; };
__device__ __forceinline__ XcdBarrier xcd_barrier_post(unsigned* bar, volatile LAS unsigned* st) {
    XcdBarrier b; b.bar = bar; b.x = xb_xcc_id(); b.st = st;
    if (threadIdx.x == 0) (void)xb_add(&bar[XB_XCNT(b.x)], 1u);
    return b;
}
__device__ __forceinline__ void xcd_barrier_complete(unsigned* bar, unsigned x, unsigned& nloc, unsigned& nx) {
    const unsigned G = gridDim.x * gridDim.y * gridDim.z;
    unsigned sum, cnt, mine, sp = 0u;
    for (;;) {
        sum = 0u; cnt = 0u; mine = 0u;
#pragma unroll
        for (unsigned j = 0; j < 16; ++j) { const unsigned c = xb_ld(&bar[XB_XCNT(j)]); sum += c; cnt += (c > 0u) ? 1u : 0u; mine = (j == x) ? c : mine; }
        if (sum == G) break;
        __builtin_amdgcn_s_sleep(1);
        if ((++sp & 255u) == 0u) { if (xb_ld(&bar[XB_TMO])) break; if (sp > XB_SPIN_CAP) { atomicAdd(&bar[XB_TMO], 1u); break; } }
    }
    nloc = mine > 0u ? mine : 1u; nx = cnt > 0u ? cnt : 1u;
}
__device__ __forceinline__ void xcd_barrier(const XcdBarrier& b) {
    asm volatile("s_waitcnt vmcnt(0)" ::: "memory");
    __syncthreads();
    if (threadIdx.x == 0) {
        unsigned* bar = b.bar;
        __builtin_amdgcn_s_waitcnt(0);
        unsigned nloc = b.st[0], nx = b.st[1];
        if (nloc == 0u) { xcd_barrier_complete(bar, b.x, nloc, nx); b.st[0] = nloc; b.st[1] = nx; }
        const unsigned old = xb_add(&bar[XB_XSUB(b.x)], 1u);
        const unsigned gen = old / nloc;
        if (old + 1u == (gen + 1u) * nloc) {
            __builtin_amdgcn_fence(__ATOMIC_RELEASE, "agent");
            asm volatile("s_waitcnt vmcnt(0)" ::: "memory");
            const unsigned og = xb_add(&bar[XB_TOP], 1u);
            const unsigned tg = og / nx;
            if (og + 1u == (tg + 1u) * nx) xb_add(&bar[XB_TOPGEN], 1u);
            else XB_SPIN(xb_ld(&bar[XB_TOPGEN]) == tg, bar);
            __builtin_amdgcn_fence(__ATOMIC_ACQUIRE, "agent");
            xb_add(&bar[XB_XGEN(b.x)], 1u);
            asm volatile("s_waitcnt vmcnt(0)" ::: "memory");
        } else {
            XB_SPIN(xb_ld(&bar[XB_XGEN(b.x)]) == gen, bar);
            __builtin_amdgcn_fence(__ATOMIC_ACQUIRE, "agent");
            asm volatile("s_waitcnt vmcnt(0)" ::: "memory");
        }
    }
    __syncthreads();
}

__global__ void __launch_bounds__(NWAVES * 64, 2) fwd_megakernel(Args a) {
    extern __shared__ __attribute__((aligned(16))) unsigned char lds_raw[];
    cg::grid_group grid = cg::this_grid();
    LAS unsigned char* lds = (LAS unsigned char*)lds_raw;
    const int tid = threadIdx.x, lane = tid & 63, wave = __builtin_amdgcn_readfirstlane(tid >> 6);
    const int G = gridDim.x, bx = blockIdx.x;
    const int gw = bx * NWAVES + wave, ngw = G * NWAVES, gtid = bx * (NWAVES * 64) + tid, nthreads = G * NWAVES * 64;
    unsigned char* ws = a.ws;
    float* X = a.out;
    float* SSQX = (float*)(ws + WS_SSQX); float* SSQM = (float*)(ws + WS_SSQM);
    bf16_t* MEMB = (bf16_t*)(ws + WS_MEMB); bf16_t* MK = (bf16_t*)(ws + WS_MK); bf16_t* MVT = (bf16_t*)(ws + WS_MVT); bf16_t* MKVW = (bf16_t*)(ws + WS_MKVW);
    bf16_t* XB = (bf16_t*)(ws + WS_XB); bf16_t* KSH = (bf16_t*)(ws + WS_KSH); bf16_t* VT = (bf16_t*)(ws + WS_VT); bf16_t* PACT = (bf16_t*)(ws + WS_PACT);
    LAS float* scr = (LAS float*)(lds + wave * 16384);
    volatile LAS unsigned* MISC = (volatile LAS unsigned*)(lds + 131072 + 320);
    if (tid < 32) MISC[tid] = 0u;
    __syncthreads();
    const XcdBarrier bar = xcd_barrier_post((unsigned*)(ws + WS_CTL) + 4096, MISC + 8);

    {
        int base = 0;
#pragma unroll 1
        for (int l = 0; l < 4; ++l) conv_job(base, a.in[8] + (size_t)l * DM * 512, DM, 512, a.in[14], 1.0f, MKVW, DM, MAP_ID, l * 512, scr, gw, ngw, lane);
        convert_layer(a, 0, base, scr, gw, ngw, lane);
        convert_layer(a, 1, base, scr, gw, ngw, lane);
        for (int m = gw; m < TT; m += ngw) row_to_bf16_ssq(a.in[0] + (size_t)m * DM, XB + (size_t)m * DM, SSQX + (size_t)m * 16, lane);
        for (int m = gw; m < MROWS; m += ngw) row_to_bf16_ssq(a.in[1] + (size_t)m * DM, MEMB + (size_t)m * DM, SSQM + (size_t)m * 16, lane);
    }
    if (G > 65536) grid.sync();
    xcd_barrier(bar);

#pragma unroll 1
    for (int l = 0; l < 4; ++l) {
        unsigned char* slot = ws + WS_WSLOT + (size_t)(l & 1) * SLOT_BYTES;
        const int pitch = (l < 2) ? PA : PB;
#pragma unroll 1
        for (int ph = (l == 0) ? -1 : 0; ph < 4; ++ph) {
            pg8::Gemm g; pg8::StaticOrder S; pg8::EpiAny E;
            E.pj = pg8::EpiProj{SSQX, PACT, pitch, (l < 2) ? 10 : 4, KSH, (l < 2) ? 0 : 3, VT};
            E.mk = pg8::EpiMKV{SSQM, MK, MVT};
            E.sw = pg8::EpiSwiGLU{SSQX, PACT, FF};
            E.rs = pg8::EpiRes{(l == 0 && ph == 1) ? a.in[0] : (const float*)X, X, XB, SSQX};
            int corder = bx;
            if (ph == -1)     { g = pg8::Gemm{MEMB, MKVW, MROWS, 2048, DM, DM}; E.mode = pg8::EM_MKV; corder = (bx + G / 2) % G; }
            else if (ph == 0) { g = pg8::Gemm{XB, (const bf16_t*)(slot + SL_WIN), TT, (l == 3) ? 1024 : 2560, DM, DM}; E.mode = pg8::EM_PROJ; }
            else if (ph == 1) { g = pg8::Gemm{PACT, (const bf16_t*)(slot + SL_WO), TT, DM, DM, pitch}; E.mode = pg8::EM_RES; }
            else if (ph == 2) { g = pg8::Gemm{XB, (const bf16_t*)(slot + SL_WGU), TT, 2 * FF, DM, DM}; E.mode = pg8::EM_SWIGLU; }
            else              { g = pg8::Gemm{PACT, (const bf16_t*)(slot + SL_WD), TT, DM, FF, FF}; E.mode = pg8::EM_RES; }
            S.init(g.M, g.N, G, corder);
            pg8::gemm_phase<pg8::EpiAny, pg8::StaticOrder, true>(lds, g, S, E);
            if (ph == -1) continue;
            xcd_barrier(bar);
            if (ph == 0) {
                int tid2 = threadIdx.x; asm volatile("" : "+v"(tid2)); const int lane2 = tid2 & 63, gtid2 = bx * (NWAVES * 64) + tid2;
                if (l < 2) conv_items(PACT, a.in[4] + (size_t)l * 3 * MAINW, gtid2, nthreads);
                else for (int it = gw; it < NB * NHSB * 128; it += ngw) sb_attn_item(PACT, KSH, VT, it, lane2);
                for (int it = gw; it < NB * NHM * 128; it += ngw) mem_attn_item(PACT, pitch, MK + (size_t)l * MROWS * 256, MVT + (size_t)l * MROWS * 256, it, lane2);
                if (l == 1 || l == 2) { int base = 0; convert_layer(a, l + 1, base, scr, gw, ngw, lane2); }
                xcd_barrier(bar);
            }
        }
    }
    for (int m = gw; m < TT; m += ngw) final_row(X + (size_t)m * DM, a.in[15], lane);
}

extern "C" void kernel_launch(void* const* d_in, const int* in_sizes, int n_in, void* d_out, int out_size, void* d_ws, size_t ws_size, hipStream_t stream) {
    static int grid = 0;
    if (grid == 0) {
        if (n_in != 16 || out_size != TT * DM || ws_size < WS_END) { fprintf(stderr, "kernel_launch: unexpected shapes (n_in %d, out %d, ws %zu)\n", n_in, out_size, ws_size); grid = -1; return; }
        int dev = 0, cus = 0, per_cu = 0;
        hipGetDevice(&dev); hipDeviceGetAttribute(&cus, hipDeviceAttributeMultiprocessorCount, dev);
        hipFuncSetAttribute((const void*)fwd_megakernel, hipFuncAttributeMaxDynamicSharedMemorySize, LDS_BYTES);
        hipOccupancyMaxActiveBlocksPerMultiprocessor(&per_cu, (const void*)fwd_megakernel, NWAVES * 64, LDS_BYTES);
        (void)hipGetLastError();
        if (per_cu < 1) per_cu = 1;
        grid = cus;
    }
    if (grid < 0) return;
    if (hipMemsetAsync((char*)d_ws + WS_CTL, 0, CTL_ZERO_BYTES, stream) != hipSuccess) { fprintf(stderr, "kernel_launch: memset failed\n"); return; }
    Args a{};
    for (int i = 0; i < 16; ++i) a.in[i] = (const float*)d_in[i];
    a.out = (float*)d_out; a.ws = (unsigned char*)d_ws;
    void* args[] = {&a};
    hipError_t e = hipLaunchCooperativeKernel((const void*)fwd_megakernel, dim3(grid), dim3(NWAVES * 64), args, LDS_BYTES, stream);
    if (e != hipSuccess) fprintf(stderr, "cooperative launch failed: %s (grid %d)\n", hipGetErrorString(e), grid);
}
```
